# Optimizing an MI355X kernel written in HIP

```python
import numpy as np
import jax
import jax.numpy as jnp
from jax import lax

D_MODEL = 2048
BATCH = 8
SEQ = 4096
DEPTH = 4

GRID_W = 64
CTX_LEN = 256
N_MIXERS = 2
N_LAYERS_A = (DEPTH + N_MIXERS - 1) // N_MIXERS
N_LAYERS_B = DEPTH // N_MIXERS
N_MOD = 6
D_FF = 4 * D_MODEL
RMS_EPS = 1e-6

ML_HEADS = 8
ML_DV = D_MODEL // ML_HEADS
ML_DQK = ML_DV // 2
ML_QK_W = ML_HEADS * ML_DQK
ML_V_W = ML_HEADS * ML_DV
ML_IN_W = 2 * ML_QK_W + 2 * ML_V_W + 4 * ML_HEADS
ML_CHUNK = 64
GATE_CAP = 15.0
FGATE_BIAS_LO = 3.0
FGATE_BIAS_HI = 6.0
ROPE_BASE = 10000.0

NA_HEADS = 16
NA_HEAD_DIM = D_MODEL // NA_HEADS
NA_KH = 8
NA_KW = 16

kernel_name = 'hybrid_mlstm_natten_dit'


def rmsnorm(x, g):
    xf = x.astype(jnp.float32)
    xf = xf * lax.rsqrt(jnp.mean(xf * xf, axis=-1, keepdims=True) + RMS_EPS)
    return xf.astype(x.dtype) * g


def axial_rope(x, row, col):
    d = x.shape[-1]
    half = d // 2
    nf = half // 2
    inv = ROPE_BASE ** (-jnp.arange(nf, dtype=jnp.float32) / nf)

    def rot(xa, pos):
        ang = pos.astype(jnp.float32)[:, None] * inv
        cos = jnp.cos(ang)[None, :, None, :]
        sin = jnp.sin(ang)[None, :, None, :]
        x1 = xa[..., :nf].astype(jnp.float32)
        x2 = xa[..., nf:].astype(jnp.float32)
        return jnp.concatenate([x1 * cos - x2 * sin, x1 * sin + x2 * cos], axis=-1)

    out = jnp.concatenate([rot(x[..., :half], row), rot(x[..., half:], col)], axis=-1)
    return out.astype(x.dtype)


def _to_chunks(a):
    b, t = a.shape[:2]
    a = a.reshape((b, t // ML_CHUNK, ML_CHUNK) + a.shape[2:])
    a = jnp.moveaxis(a, 3, 2)
    return jnp.moveaxis(a, 1, 0)


def _zero_state(bsz):
    f32 = jnp.float32
    return (jnp.zeros((bsz, ML_HEADS, ML_DQK, ML_DV), f32),
            jnp.zeros((bsz, ML_HEADS, ML_DQK), f32),
            jnp.zeros((bsz, ML_HEADS), f32))


def mlstm_chunkwise(q, k, v, ig, lf, state):
    bsz, t = q.shape[:2]
    f32 = jnp.float32
    qs, ks, vs = (_to_chunks(a.astype(f32)) for a in (q, k, v))
    igs, lfs = _to_chunks(ig), _to_chunks(lf)
    earlier = np.tril(np.ones((ML_CHUNK, ML_CHUNK), dtype=bool))

    def body(carry, inp):
        C, n, m = carry
        qc, kc, vc, igc, lfc = inp
        b = jnp.cumsum(lfc, axis=-1)
        a = b + m[..., None]
        dmat = b[..., :, None] - b[..., None, :] + igc[..., None, :]
        dmat = jnp.where(earlier, dmat, -jnp.inf)
        m_s = jnp.maximum(a, jnp.max(dmat, axis=-1))
        w_state = jnp.exp(a - m_s)
        s = jnp.einsum('bhsd,bhjd->bhsj', qc, kc) * jnp.exp(dmat - m_s[..., None])
        num = w_state[..., None] * jnp.einsum('bhsd,bhde->bhse', qc, C) + jnp.einsum('bhsj,bhje->bhse', s, vc)
        den = w_state * jnp.einsum('bhsd,bhd->bhs', qc, n) + jnp.sum(s, axis=-1)
        h = num / jnp.maximum(jnp.abs(den), jnp.exp(-m_s))[..., None]
        b_tot = b[..., -1]
        g = b_tot[..., None] - b + igc
        m_new = jnp.maximum(b_tot + m, jnp.max(g, axis=-1))
        decay = jnp.exp(b_tot + m - m_new)
        wk = jnp.exp(g - m_new[..., None])
        C_new = decay[..., None, None] * C + jnp.einsum('bhj,bhjd,bhje->bhde', wk, kc, vc)
        n_new = decay[..., None] * n + jnp.einsum('bhj,bhjd->bhd', wk, kc)
        return (C_new, n_new, m_new), h

    final, h = lax.scan(body, state, (qs, ks, vs, igs, lfs))
    h = jnp.moveaxis(jnp.moveaxis(h, 0, 1), 2, 3)
    return h.reshape(bsz, t, ML_HEADS, ML_DV), final


def _mlstm_project(z, w_in, b_gate, row, col):
    bsz, t, _ = z.shape
    p = z @ w_in
    q, k, v, og, g = jnp.split(p, [ML_QK_W, 2 * ML_QK_W, 2 * ML_QK_W + ML_V_W, 2 * ML_QK_W + 2 * ML_V_W], axis=-1)
    q = q.reshape(bsz, t, ML_HEADS, ML_DQK)
    k = k.reshape(bsz, t, ML_HEADS, ML_DQK)
    if row is not None:
        q = axial_rope(q, row, col)
        k = axial_rope(k, row, col)
    k = k * (ML_DQK ** -0.5)
    v = v.reshape(bsz, t, ML_HEADS, ML_DV)
    g = g.astype(jnp.float32) + b_gate.astype(jnp.float32)
    g = (GATE_CAP * jnp.tanh(g / GATE_CAP)).reshape(bsz, t, 4, ML_HEADS)
    fwd = (g[:, :, 0], jax.nn.log_sigmoid(g[:, :, 1]))
    bwd = (g[:, :, 2], jax.nn.log_sigmoid(g[:, :, 3]))
    return q, k, v, og, fwd, bwd


def _mlstm_readout(h, og, norm_g, w_out):
    bsz, t = h.shape[:2]
    hf = h * lax.rsqrt(jnp.mean(h * h, axis=-1, keepdims=True) + RMS_EPS)
    hf = hf.reshape(bsz, t, ML_V_W).astype(og.dtype) * norm_g
    return (hf * jax.nn.sigmoid(og)) @ w_out


def mlstm_mixer(u, uc, w_in, b_gate, norm_g, w_out, row, col, need_ctx):
    q, k, v, og, gf, gb = _mlstm_project(u, w_in, b_gate, row, col)
    qc, kc, vc, ogc, gcf, gcb = _mlstm_project(uc, w_in, b_gate, None, None)
    flip = lambda a: jnp.flip(a, axis=1)
    s0 = _zero_state(u.shape[0])
    hcf, scf = mlstm_chunkwise(qc, kc, vc, gcf[0], gcf[1], s0)
    hf, _ = mlstm_chunkwise(q, k, v, gf[0], gf[1], scf)
    hcb, scb = mlstm_chunkwise(flip(qc), flip(kc), flip(vc), flip(gcb[0]), flip(gcb[1]), s0)
    hb, _ = mlstm_chunkwise(flip(q), flip(k), flip(v), flip(gb[0]), flip(gb[1]), scb)
    y = _mlstm_readout(hf + flip(hb), og, norm_g, w_out)
    if not need_ctx:
        return y, None
    yc = _mlstm_readout(hcf + flip(hcb), ogc, norm_g, w_out)
    return y, yc


def neighbourhood_attention(q, k, v, kc, vc, rpb, n_rows):
    bsz, t, h, dh = q.shape
    kh = min(NA_KH, n_rows)
    kw = NA_KW
    scale = dh ** -0.5
    qg = q.reshape(bsz, n_rows, GRID_W, h, dh)
    kg = k.reshape(bsz, n_rows, GRID_W, h, dh)
    vg = v.reshape(bsz, n_rows, GRID_W, h, dh)
    cols = np.arange(GRID_W)
    c_start = np.clip(cols - kw // 2, 0, GRID_W - kw)
    cidx = c_start[:, None] + np.arange(kw)[None, :]
    col_off = cidx - cols[:, None] + (NA_KW - 1)
    rpb_col = rpb[:, :, col_off]

    def row_block(r):
        r_start = jnp.clip(r - kh // 2, 0, n_rows - kh)
        qr = lax.dynamic_index_in_dim(qg, r, axis=1, keepdims=False)
        kband = lax.dynamic_slice_in_dim(kg, r_start, kh, axis=1)
        vband = lax.dynamic_slice_in_dim(vg, r_start, kh, axis=1)
        kwin = kband[:, :, cidx]
        vwin = jnp.transpose(vband[:, :, cidx], (0, 2, 1, 3, 4, 5)).reshape(bsz, GRID_W, kh * kw, h, dh)
        row_off = r_start + jnp.arange(kh) - r + (NA_KH - 1)
        bias = jnp.transpose(jnp.take(rpb_col, row_off, axis=1), (0, 2, 1, 3))
        s_win = jnp.einsum('bqhd,brqwhd->bhqrw', qr, kwin) * scale + bias[None]
        s_ctx = jnp.einsum('bqhd,bchd->bhqc', qr, kc) * scale
        s = jnp.concatenate([s_win.reshape(bsz, h, GRID_W, kh * kw), s_ctx], axis=-1)
        p = jax.nn.softmax(s.astype(jnp.float32), axis=-1).astype(v.dtype)
        o = jnp.einsum('bhqn,bqnhd->bqhd', p[..., :kh * kw], vwin)
        return o + jnp.einsum('bhqc,bchd->bqhd', p[..., kh * kw:], vc)

    out = lax.map(row_block, jnp.arange(n_rows))
    return jnp.transpose(out, (1, 0, 2, 3, 4)).reshape(bsz, t, h, dh)


def na_mixer(u, uc, w_qkv, rpb, w_out, n_rows, need_ctx):
    bsz, t, _ = u.shape
    lc = uc.shape[1]
    p = (u @ w_qkv).reshape(bsz, t, 3, NA_HEADS, NA_HEAD_DIM)
    pc = (uc @ w_qkv).reshape(bsz, lc, 3, NA_HEADS, NA_HEAD_DIM)
    kc, vc = pc[:, :, 1], pc[:, :, 2]
    o = neighbourhood_attention(p[:, :, 0], p[:, :, 1], p[:, :, 2], kc, vc, rpb, n_rows)
    y = o.reshape(bsz, t, D_MODEL) @ w_out
    if not need_ctx:
        return y, None
    s = jnp.einsum('bqhd,bkhd->bhqk', pc[:, :, 0], kc) * (NA_HEAD_DIM ** -0.5)
    pr = jax.nn.softmax(s.astype(jnp.float32), axis=-1).astype(vc.dtype)
    yc = jnp.einsum('bhqk,bkhd->bqhd', pr, vc).reshape(bsz, lc, D_MODEL) @ w_out
    return y, yc


def sq_relu_mlp(u, w1, w2):
    return jnp.square(jax.nn.relu(u @ w1)) @ w2


def setup_inputs(seed: int = 0) -> dict:
    key = jax.random.key(seed)
    ks = jax.random.split(key, 18)
    f32 = jnp.float32

    def nrm(k, shape, scale):
        return jax.random.normal(k, shape, f32) * scale

    f_bias = jnp.linspace(FGATE_BIAS_LO, FGATE_BIAS_HI, ML_HEADS, dtype=f32)
    zeros_h = jnp.zeros((ML_HEADS,), f32)
    gate_off = jnp.stack([zeros_h, f_bias, zeros_h, f_bias], axis=0)
    ml_b_gate = (nrm(ks[9], (N_LAYERS_A, 4, ML_HEADS), 0.1) + gate_off).reshape(N_LAYERS_A, 4 * ML_HEADS)
    return {
        'x': nrm(ks[0], (BATCH, SEQ, D_MODEL), 1.0),
        'c': nrm(ks[1], (BATCH, D_MODEL), 1.0),
        'ctx': nrm(ks[2], (BATCH, CTX_LEN, D_MODEL), 1.0),
        'c_ctx': nrm(ks[3], (D_MODEL,), 1.0),
        'ada_w': nrm(ks[4], (DEPTH, D_MODEL, N_MOD * D_MODEL), 0.5 * D_MODEL ** -0.5),
        'ada_b': nrm(ks[5], (DEPTH, N_MOD * D_MODEL), 0.02),
        'norm_mix': 1.0 + nrm(ks[6], (DEPTH, D_MODEL), 0.02),
        'norm_mlp': 1.0 + nrm(ks[7], (DEPTH, D_MODEL), 0.02),
        'ml_w_in': nrm(ks[8], (N_LAYERS_A, D_MODEL, ML_IN_W), D_MODEL ** -0.5),
        'ml_b_gate': ml_b_gate,
        'ml_norm': 1.0 + nrm(ks[10], (N_LAYERS_A, ML_V_W), 0.02),
        'ml_w_out': nrm(ks[11], (N_LAYERS_A, ML_V_W, D_MODEL), ML_V_W ** -0.5),
        'na_w_qkv': nrm(ks[12], (N_LAYERS_B, D_MODEL, 3 * D_MODEL), D_MODEL ** -0.5),
        'na_rpb': nrm(ks[13], (N_LAYERS_B, NA_HEADS, 2 * NA_KH - 1, 2 * NA_KW - 1), 0.5),
        'na_w_out': nrm(ks[14], (N_LAYERS_B, D_MODEL, D_MODEL), D_MODEL ** -0.5),
        'mlp_w1': nrm(ks[15], (DEPTH, D_MODEL, D_FF), D_MODEL ** -0.5),
        'mlp_w2': nrm(ks[16], (DEPTH, D_FF, D_MODEL), D_FF ** -0.5),
        'final_norm': 1.0 + nrm(ks[17], (D_MODEL,), 0.02),
    }


def reference(x, c, ctx, c_ctx, ada_w, ada_b, norm_mix, norm_mlp, ml_w_in, ml_b_gate, ml_norm, ml_w_out,
              na_w_qkv, na_rpb, na_w_out, mlp_w1, mlp_w2, final_norm):
    t = x.shape[1]
    n_rows = t // GRID_W
    pos = jnp.arange(t, dtype=jnp.int32)
    row, col = pos // GRID_W, pos % GRID_W
    cond_lat = jax.nn.silu(c)
    cond_ctx = jax.nn.silu(c_ctx)
    h, hc = x, ctx
    for i in range(DEPTH):
        need_ctx = i < DEPTH - 1
        mx = (cond_lat @ ada_w[i] + ada_b[i])[:, None, :]
        mc = cond_ctx @ ada_w[i] + ada_b[i]
        sh1, sc1, g1, sh2, sc2, g2 = jnp.split(mx, N_MOD, axis=-1)
        csh1, csc1, cg1, csh2, csc2, cg2 = jnp.split(mc, N_MOD, axis=-1)
        u = rmsnorm(h, norm_mix[i]) * (1 + sc1) + sh1
        uc = rmsnorm(hc, norm_mix[i]) * (1 + csc1) + csh1
        j = i // N_MIXERS
        if i % N_MIXERS == 0:
            y, yc = mlstm_mixer(u, uc, ml_w_in[j], ml_b_gate[j], ml_norm[j], ml_w_out[j], row, col, need_ctx)
        else:
            y, yc = na_mixer(u, uc, na_w_qkv[j], na_rpb[j], na_w_out[j], n_rows, need_ctx)
        h = h + g1 * y
        u = rmsnorm(h, norm_mlp[i]) * (1 + sc2) + sh2
        h = h + g2 * sq_relu_mlp(u, mlp_w1[i], mlp_w2[i])
        if need_ctx:
            hc = hc + cg1 * yc
            uc = rmsnorm(hc, norm_mlp[i]) * (1 + csc2) + csh2
            hc = hc + cg2 * sq_relu_mlp(uc, mlp_w1[i], mlp_w2[i])
    return rmsnorm(h, final_norm)
```

```cpp
#include <hip/hip_runtime.h>
#include <cstdio>
#include <cstdint>
#include <cmath>
#ifndef MK_PER_PHASE
#define MK_PER_PHASE 0
#endif
namespace pg8 {
#define PG8_LAS __attribute__((address_space(3)))
typedef unsigned short bf16_t;
typedef short bf16x8 __attribute__((ext_vector_type(8)));
typedef float f32x4 __attribute__((ext_vector_type(4)));
typedef unsigned u32x4 __attribute__((ext_vector_type(4)));
constexpr int BM = 256, BK = 64, HALF = 128, HTB = HALF * BK * 2  , STAGE_BYTES = 8 * HTB, NXCD = 8, WGM = 8;

__host__ __device__ __forceinline__ int lds_byte(int r, int c) { const int st = (r >> 4) * 2 + (c >> 5), rr = r & 15, cc = c & 31, ob = rr * 64 + cc * 2; return st * 1024 + (ob ^ (((ob >> 9) & 1) << 5)); }
__host__ __device__ __forceinline__ void stage_rc(int b, int& R, int& C) { const int st = b / 1024, sb = b % 1024, swz = sb ^ (((sb >> 9) & 1) << 5); R = (st >> 1) * 16 + swz / 64; C = (st & 1) * 32 + (swz % 64) / 2; }
__host__ __device__ __forceinline__ int perm32(int rho) { const int n = rho >> 4, i = rho & 15; return 8 * (i >> 2) + 4 * n + (i & 3); }

struct Unit { int pm, pn; };
struct Gemm { const bf16_t* A; const bf16_t* Bt; int M, N, K; };

struct StaticOrder {
    int nM, nN, nwg, G, c;
    __host__ __device__ void init(int M, int N, int G_, int c_) { nM = M / BM; nN = N / BM; nwg = nM * nN; G = G_; c = c_; }
    __host__ __device__ bool next(int i, Unit& u) const {
        const long L = (long)i * G + c; if (L >= nwg) return false;
        int wgid = (int)L; { const int q = nwg / NXCD, r = nwg % NXCD, xcd = wgid % NXCD, off = wgid / NXCD; wgid = (xcd < r ? xcd * (q + 1) : r * (q + 1) + (xcd - r) * q) + off; }
        const int nig = WGM * nN, gid = wgid / nig, fm = gid * WGM, gsz = (nM - fm) < WGM ? (nM - fm) : WGM;
        u.pm = fm + ((wgid % nig) % gsz); u.pn = (wgid % nig) / gsz; return true;
    }
    __device__ __forceinline__ void a_ready(const Unit&) const {}
    __device__ __forceinline__ void done(const Unit&) const {}
};

struct Order8 {
    int nN, nwg, G, c, q;
    __host__ __device__ void init(int M, int N, int G_, int c_) { nN = N / BM; nwg = (M / BM) * nN; G = G_; c = c_; q = nwg / NXCD; }
    __host__ __device__ bool next(int i, Unit& u) const {
        const int L = i * G + c; if (L >= nwg) return false;
        const int wgid = (L % NXCD) * q + L / NXCD, nig = WGM * nN, gid = wgid / nig, w = wgid % nig;
        u.pm = gid * WGM + (w % WGM); u.pn = w / WGM; return true;
    }
    __device__ __forceinline__ void a_ready(const Unit&) const {}
    __device__ __forceinline__ void done(const Unit&) const {}
};

__device__ __forceinline__ unsigned cvt_pk_bf16(float lo, float hi) { unsigned r; asm volatile("v_cvt_pk_bf16_f32 %0, %1, %2" : "=v"(r) : "v"(lo), "v"(hi)); return r; }
typedef float f32x2 __attribute__((ext_vector_type(2)));

constexpr int E_DM = 2048, E_NMOD = 12288, E_ML = 32768;
struct EpiRes {
    static constexpr bool PERM = false, AFTER_DRAIN = false;
    float* hl; float* hc; const float* mods; int goff;
    __device__ __forceinline__ void operator()(const f32x4 (&acc)[2][2][4][2], const Unit& u, int wr, int wc, int fr, int fq) const {
        const bool isc = u.pm >= 128; const int bidx = isc ? 8 : (u.pm >> 4);
        float* base = isc ? hc + (size_t)(u.pm - 128) * 256 * E_DM : hl + (size_t)u.pm * 256 * E_DM;
        const int col0 = u.pn * BM + wc * 32 + 4 * fq, rl = wr * 64 + fr;
        const float* gp = mods + bidx * E_NMOD + goff + col0;
        f32x4 gv[2][2];
#pragma unroll
        for (int bj = 0; bj < 2; ++bj)
#pragma unroll
            for (int n = 0; n < 2; ++n) gv[bj][n] = *(const f32x4*)(gp + bj * HALF + n * 16);
#pragma unroll
        for (int ai = 0; ai < 2; ++ai)
#pragma unroll
            for (int m = 0; m < 4; ++m) { float* rowp = base + (size_t)(rl + ai * HALF + m * 16) * E_DM + col0;
#pragma unroll
                for (int bj = 0; bj < 2; ++bj)
#pragma unroll
                    for (int n = 0; n < 2; ++n) { f32x4* p = (f32x4*)(rowp + bj * HALF + n * 16); const f32x4 o = *p + gv[bj][n] * acc[ai][bj][m][n]; *p = o; }
                asm volatile("" ::: "memory"); }
    }
};
struct EpiSqRelu {
    static constexpr bool PERM = true, AFTER_DRAIN = false;
    bf16_t* O; int ldc;
    __device__ __forceinline__ void operator()(const f32x4 (&acc)[2][2][4][2], const Unit& u, int wr, int wc, int fr, int fq) const {
        const int row0 = u.pm * BM + wr * 64 + fr, col0 = u.pn * BM + wc * 32 + 8 * fq;
#pragma unroll
        for (int ai = 0; ai < 2; ++ai)
#pragma unroll
            for (int m = 0; m < 4; ++m) { bf16_t* rowp = O + (size_t)(row0 + ai * HALF + m * 16) * ldc + col0;
#pragma unroll
                for (int bj = 0; bj < 2; ++bj) { f32x4 v0 = acc[ai][bj][m][0], v1 = acc[ai][bj][m][1];
#pragma unroll
                    for (int j = 0; j < 4; ++j) { const float a = fmaxf(v0[j], 0.f), b = fmaxf(v1[j], 0.f); v0[j] = a * a; v1[j] = b * b; }
                    u32x4 w; w.x = cvt_pk_bf16(v0[0], v0[1]); w.y = cvt_pk_bf16(v0[2], v0[3]); w.z = cvt_pk_bf16(v1[0], v1[1]); w.w = cvt_pk_bf16(v1[2], v1[3]);
                    *(u32x4*)(rowp + bj * HALF) = w; } }
    }
};
struct EpiQKV {
    static constexpr bool PERM = true, AFTER_DRAIN = false;
    bf16_t* O; int ldc; int qtiles; float qscale;
    __device__ __forceinline__ void operator()(const f32x4 (&acc)[2][2][4][2], const Unit& u, int wr, int wc, int fr, int fq) const {
        const int row0 = u.pm * BM + wr * 64 + fr, col0 = u.pn * BM + wc * 32 + 8 * fq; const float sc = u.pn < qtiles ? qscale : 1.f;
#pragma unroll
        for (int ai = 0; ai < 2; ++ai)
#pragma unroll
            for (int m = 0; m < 4; ++m) { bf16_t* rowp = O + (size_t)(row0 + ai * HALF + m * 16) * ldc + col0;
#pragma unroll
                for (int bj = 0; bj < 2; ++bj) { const f32x4 v0 = acc[ai][bj][m][0] * sc, v1 = acc[ai][bj][m][1] * sc;
                    u32x4 w; w.x = cvt_pk_bf16(v0[0], v0[1]); w.y = cvt_pk_bf16(v0[2], v0[3]); w.z = cvt_pk_bf16(v1[0], v1[1]); w.w = cvt_pk_bf16(v1[2], v1[3]);
                    *(u32x4*)(rowp + bj * HALF) = w; } }
    }
};
struct EpiMl {
    static constexpr bool PERM = true, AFTER_DRAIN = false;
    bf16_t *Q, *K, *V, *OG; float* G; const float* bgate; const float* rope;
    __device__ __forceinline__ void operator()(const f32x4 (&acc)[2][2][4][2], const Unit& u, int wr, int wc, int fr, int fq) const {
        const int row0 = u.pm * BM + wr * 64 + fr;
        if (u.pn < 8) {
            bf16_t* dst = u.pn < 4 ? Q : K; const float ksc = u.pn < 4 ? 1.f : 0.08838834764831845f; const bool lat = u.pm < 128;
            const int col0 = (u.pn & 3) * BM + wc * 32 + 8 * fq, half = wc >> 1, j0 = 16 * (wc & 1) + 4 * fq;
#pragma unroll
            for (int ai = 0; ai < 2; ++ai)
#pragma unroll
                for (int m = 0; m < 4; ++m) {
                    const int pos = half ? (16 * m + fr) : ((4 * u.pm + 2 * ai + wr) & 63);
                    const f32x4* rp = (const f32x4*)(rope + (pos * 32 + j0) * 2); const f32x4 cs0 = rp[0], cs1 = rp[1];
                    bf16_t* rowp = dst + (size_t)(row0 + ai * HALF + m * 16) * 1024 + col0;
#pragma unroll
                    for (int bj = 0; bj < 2; ++bj) { f32x4 v0 = acc[ai][bj][m][0], v1 = acc[ai][bj][m][1];
                        if (lat) { f32x4 r0, r1;
                            r0[0] = v0[0] * cs0[0] - v0[1] * cs0[1]; r0[1] = v0[0] * cs0[1] + v0[1] * cs0[0];
                            r0[2] = v0[2] * cs0[2] - v0[3] * cs0[3]; r0[3] = v0[2] * cs0[3] + v0[3] * cs0[2];
                            r1[0] = v1[0] * cs1[0] - v1[1] * cs1[1]; r1[1] = v1[0] * cs1[1] + v1[1] * cs1[0];
                            r1[2] = v1[2] * cs1[2] - v1[3] * cs1[3]; r1[3] = v1[2] * cs1[3] + v1[3] * cs1[2];
                            v0 = r0; v1 = r1; }
                        v0 = v0 * ksc; v1 = v1 * ksc;
                        u32x4 w; w.x = cvt_pk_bf16(v0[0], v0[1]); w.y = cvt_pk_bf16(v0[2], v0[3]); w.z = cvt_pk_bf16(v1[0], v1[1]); w.w = cvt_pk_bf16(v1[2], v1[3]);
                        *(u32x4*)(rowp + bj * HALF) = w; } }
        } else if (u.pn < 24) {
            const bool isog = u.pn >= 16; bf16_t* dst = isog ? OG : V; const int col0 = ((u.pn - 8) & 7) * BM + wc * 32 + 8 * fq;
#pragma unroll
            for (int ai = 0; ai < 2; ++ai)
#pragma unroll
                for (int m = 0; m < 4; ++m) { bf16_t* rowp = dst + (size_t)(row0 + ai * HALF + m * 16) * 2048 + col0;
#pragma unroll
                    for (int bj = 0; bj < 2; ++bj) { f32x4 v0 = acc[ai][bj][m][0], v1 = acc[ai][bj][m][1];
                        if (isog) {
#pragma unroll
                            for (int j = 0; j < 4; ++j) { v0[j] = 1.f / (1.f + __expf(-v0[j])); v1[j] = 1.f / (1.f + __expf(-v1[j])); } }
                        u32x4 w; w.x = cvt_pk_bf16(v0[0], v0[1]); w.y = cvt_pk_bf16(v0[2], v0[3]); w.z = cvt_pk_bf16(v1[0], v1[1]); w.w = cvt_pk_bf16(v1[2], v1[3]);
                        *(u32x4*)(rowp + bj * HALF) = w; } }
        } else if (wc == 0) {
            const f32x4 b0 = *(const f32x4*)(bgate + 8 * fq), b1 = *(const f32x4*)(bgate + 8 * fq + 4); const bool isf = (fq & 1) != 0;
#pragma unroll
            for (int ai = 0; ai < 2; ++ai)
#pragma unroll
                for (int m = 0; m < 4; ++m) { f32x4 v0 = acc[ai][0][m][0] + b0, v1 = acc[ai][0][m][1] + b1;
#pragma unroll
                    for (int j = 0; j < 4; ++j) {
                        float a = v0[j] * (1.f / 15.f), b = v1[j] * (1.f / 15.f);
                        a = 15.f * (1.f - 2.f / (__expf(2.f * a) + 1.f)); b = 15.f * (1.f - 2.f / (__expf(2.f * b) + 1.f));
                        if (isf) { a = fminf(a, 0.f) - log1pf(__expf(-fabsf(a))); b = fminf(b, 0.f) - log1pf(__expf(-fabsf(b))); }
                        v0[j] = a; v1[j] = b; }
                    float* gp = G + (size_t)(row0 + ai * HALF + m * 16) * 32 + 8 * fq; *(f32x4*)gp = v0; *(f32x4*)(gp + 4) = v1; }
        }
    }
};
template <class Epi, class Sched, bool ALIGN_EPI = false, bool SP2 = false>
__device__ __forceinline__ void gemm_phase(PG8_LAS unsigned char* lds, const Gemm g, const Sched& S, const Epi& E, const int tid_in) {
    const int tid = tid_in, wid = __builtin_amdgcn_readfirstlane(tid >> 6), lane = tid & 63, wr = wid >> 2, wc = wid & 3, fr = lane & 15, fq = lane >> 4;
    const int K = g.K, nt = K / BK;
    unsigned voffA[2], voffB[2];
#pragma unroll
    for (int i = 0; i < 2; ++i) { int R, C; stage_rc(tid * 16 + i * 8192, R, C); const int Rb = Epi::PERM ? ((R & ~31) + perm32(R & 31)) : R;
        voffA[i] = (unsigned)(R * K + C) * 2u; voffB[i] = (unsigned)(Rb * K + C) * 2u; }
    const size_t kstep = (size_t)(BK * 2);
    const size_t hstep = (size_t)HALF * K * 2;
    const size_t tstep = 2 * hstep;
    const unsigned ldsw = (unsigned)wid * 1024u;
    const int aoff = lds_byte(wr * 64 + fr, fq * 8), boff = lds_byte(wc * 32 + fr, fq * 8);
#define PG8_SA(b, h) (((b) * 2 + (h)) * HTB)
#define PG8_SB(b, h) ((4 + (b) * 2 + (h)) * HTB)
#define PG8_STAGE(bufoff, gbase, voff) do { _Pragma("unroll") for (int _i = 0; _i < 2; ++_i) \
        __builtin_amdgcn_global_load_lds((const unsigned*)((const char*)(gbase) + (voff)[_i]), (PG8_LAS unsigned*)(lds + (bufoff) + ldsw + _i * 8192), 16, 0, 0); } while (0)
#define PG8_LDA(dst, b, h) do { _Pragma("unroll") for (int m = 0; m < 4; ++m) _Pragma("unroll") for (int k = 0; k < 2; ++k) dst[m][k] = *(const PG8_LAS bf16x8*)(lds + PG8_SA(b, h) + aoff + m * 2048 + k * 1024); } while (0)
#define PG8_LDB(dst, b, h) do { _Pragma("unroll") for (int n = 0; n < 2; ++n) _Pragma("unroll") for (int k = 0; k < 2; ++k) dst[n][k] = *(const PG8_LAS bf16x8*)(lds + PG8_SB(b, h) + boff + n * 2048 + k * 1024); } while (0)
#define PG8_MMA(ai, bj, At, Bt) do { __builtin_amdgcn_s_setprio(1); _Pragma("unroll") for (int m = 0; m < 4; ++m) _Pragma("unroll") for (int n = 0; n < 2; ++n) _Pragma("unroll") for (int k = 0; k < 2; ++k) \
        acc[ai][bj][m][n] = __builtin_amdgcn_mfma_f32_16x16x32_bf16(Bt[n][k], At[m][k], acc[ai][bj][m][n], 0, 0, 0); __builtin_amdgcn_s_setprio(0); } while (0)
#define PG8_WAIT_V(n) asm volatile("s_waitcnt vmcnt(" #n ")" ::: "memory")
#define PG8_WAIT_L(n) asm volatile("s_waitcnt lgkmcnt(" #n ")" ::: "memory")
#define PG8_BAR __builtin_amdgcn_s_barrier()
#define PG8_SCHED __builtin_amdgcn_sched_barrier(0)
    Unit cur, nxt; int ui = 0;
    if (!S.next(0, cur)) return;
    f32x4 acc[2][2][4][2];
#pragma unroll
    for (int a = 0; a < 2; ++a)
#pragma unroll
        for (int b = 0; b < 2; ++b)
#pragma unroll
            for (int m = 0; m < 4; ++m)
#pragma unroll
                for (int n = 0; n < 2; ++n) acc[a][b][m][n] = (f32x4){0.f, 0.f, 0.f, 0.f};
    bf16x8 At[4][2], B0[2][2], B1[2][2];
    const char* cA = (const char*)g.A + (size_t)cur.pm * tstep; const char* cB = (const char*)g.Bt + (size_t)cur.pn * tstep;
    S.a_ready(cur);
    if constexpr (SP2) {
        PG8_STAGE(PG8_SB(0, 0), cB, voffB); PG8_STAGE(PG8_SB(0, 1), cB + hstep, voffB); PG8_STAGE(PG8_SA(0, 0), cA, voffA); PG8_STAGE(PG8_SA(0, 1), cA + hstep, voffA);
        if (wr == 1) PG8_BAR;
        PG8_WAIT_V(2); PG8_BAR;
        PG8_STAGE(PG8_SB(1, 0), cB + kstep, voffB); PG8_STAGE(PG8_SA(1, 0), cA + kstep, voffA); PG8_STAGE(PG8_SB(1, 1), cB + hstep + kstep, voffB);
        PG8_WAIT_V(6); PG8_BAR;
    } else {
        PG8_STAGE(PG8_SB(0, 0), cB, voffB); PG8_STAGE(PG8_SA(0, 0), cA, voffA); PG8_STAGE(PG8_SB(0, 1), cB + hstep, voffB); PG8_STAGE(PG8_SA(0, 1), cA + hstep, voffA);
        if (wr == 1) PG8_BAR;
        PG8_WAIT_V(4); PG8_BAR;
        PG8_STAGE(PG8_SB(1, 0), cB + kstep, voffB); PG8_STAGE(PG8_SA(1, 0), cA + kstep, voffA); PG8_STAGE(PG8_SB(1, 1), cB + hstep + kstep, voffB);
        PG8_WAIT_V(6); PG8_BAR;
    }
    for (;;) {
        const bool has_next = S.next(ui + 1, nxt);
        const char* nA = has_next ? (const char*)g.A + (size_t)nxt.pm * tstep : cA; const char* nB = has_next ? (const char*)g.Bt + (size_t)nxt.pn * tstep : cB;
        for (int t = 0; t < nt; t += 2) {
            const bool last = (t == nt - 2);
            const char* a1 = cA + (size_t)(t + 1) * kstep;
            const char* a2 = last ? nA : cA + (size_t)(t + 2) * kstep; const char* b2 = last ? nB : cB + (size_t)(t + 2) * kstep;
            const char* a3 = a2 + kstep; const char* b3 = b2 + kstep;
            if (last && has_next) S.a_ready(nxt);
            if constexpr (SP2) {
            PG8_LDB(B0, 0, 0); PG8_LDB(B1, 0, 1); PG8_SCHED; PG8_LDA(At, 0, 0); PG8_STAGE(PG8_SA(1, 1), a1 + hstep, voffA);
            PG8_WAIT_V(8); PG8_WAIT_L(0); PG8_BAR; PG8_MMA(0, 0, At, B0); PG8_MMA(0, 1, At, B1); PG8_BAR; PG8_SCHED;
            PG8_LDA(At, 0, 1); PG8_STAGE(PG8_SB(0, 0), b2, voffB); PG8_STAGE(PG8_SB(0, 1), b2 + hstep, voffB); PG8_STAGE(PG8_SA(0, 0), a2, voffA);
            PG8_WAIT_V(8); PG8_WAIT_L(0); PG8_BAR; PG8_MMA(1, 0, At, B0); PG8_MMA(1, 1, At, B1); PG8_BAR; PG8_SCHED;
            PG8_LDB(B0, 1, 0); PG8_LDB(B1, 1, 1); PG8_SCHED; PG8_LDA(At, 1, 0); PG8_STAGE(PG8_SA(0, 1), a2 + hstep, voffA);
            PG8_WAIT_V(8); PG8_WAIT_L(0); PG8_BAR; PG8_MMA(0, 0, At, B0); PG8_MMA(0, 1, At, B1); PG8_BAR; PG8_SCHED;
            PG8_LDA(At, 1, 1); PG8_STAGE(PG8_SB(1, 0), b3, voffB); PG8_STAGE(PG8_SB(1, 1), b3 + hstep, voffB); PG8_STAGE(PG8_SA(1, 0), a3, voffA);
            PG8_WAIT_V(8); PG8_WAIT_L(0); PG8_BAR; PG8_MMA(1, 0, At, B0); PG8_MMA(1, 1, At, B1); PG8_BAR; PG8_SCHED;
            } else {
            PG8_LDB(B0, 0, 0); PG8_SCHED; PG8_LDA(At, 0, 0); PG8_STAGE(PG8_SA(1, 1), a1 + hstep, voffA);
            PG8_WAIT_L(8); PG8_BAR; PG8_WAIT_L(0); PG8_MMA(0, 0, At, B0); PG8_BAR; PG8_SCHED;
            PG8_LDB(B1, 0, 1); PG8_STAGE(PG8_SB(0, 0), b2, voffB);
            PG8_BAR; PG8_WAIT_L(0); PG8_MMA(0, 1, At, B1); PG8_BAR;
            PG8_LDA(At, 0, 1); PG8_STAGE(PG8_SA(0, 0), a2, voffA);
            PG8_BAR; PG8_WAIT_L(0); PG8_MMA(1, 0, At, B0); PG8_BAR; PG8_SCHED;
            PG8_STAGE(PG8_SB(0, 1), b2 + hstep, voffB);
            PG8_WAIT_V(6); PG8_BAR; PG8_MMA(1, 1, At, B1); PG8_BAR;
            PG8_LDB(B0, 1, 0); PG8_SCHED; PG8_LDA(At, 1, 0); PG8_STAGE(PG8_SA(0, 1), a2 + hstep, voffA);
            PG8_WAIT_L(8); PG8_BAR; PG8_WAIT_L(0); PG8_MMA(0, 0, At, B0); PG8_BAR; PG8_SCHED;
            PG8_LDB(B1, 1, 1); PG8_STAGE(PG8_SB(1, 0), b3, voffB);
            PG8_BAR; PG8_WAIT_L(0); PG8_MMA(0, 1, At, B1); PG8_BAR;
            PG8_LDA(At, 1, 1); PG8_STAGE(PG8_SA(1, 0), a3, voffA);
            PG8_BAR; PG8_WAIT_L(0); PG8_MMA(1, 0, At, B0); PG8_BAR; PG8_SCHED;
            PG8_STAGE(PG8_SB(1, 1), b3 + hstep, voffB);
            PG8_WAIT_V(6); PG8_BAR; PG8_MMA(1, 1, At, B1); PG8_BAR;
            }
        }
        if constexpr (ALIGN_EPI) { if (wr == 0) PG8_BAR; }
        if constexpr (!Epi::AFTER_DRAIN) { E(acc, cur, wr, wc, fr, fq); S.done(cur); }
        if (!has_next) break;
#pragma unroll
        for (int a = 0; a < 2; ++a)
#pragma unroll
            for (int b = 0; b < 2; ++b)
#pragma unroll
                for (int m = 0; m < 4; ++m)
#pragma unroll
                    for (int n = 0; n < 2; ++n) acc[a][b][m][n] = (f32x4){0.f, 0.f, 0.f, 0.f};
        cur = nxt; cA = nA; cB = nB; ++ui;
        if constexpr (ALIGN_EPI) { if (wr == 1) PG8_BAR; }
    }
    PG8_WAIT_V(0);
    if constexpr (!ALIGN_EPI) { if (wr == 0) PG8_BAR; }
    PG8_BAR;
    if constexpr (Epi::AFTER_DRAIN) { E.fused(acc, cur, wr, wc, fr, fq, lds, wid, lane); S.done(cur); }
#undef PG8_SA
#undef PG8_SB
#undef PG8_STAGE
#undef PG8_LDA
#undef PG8_LDB
#undef PG8_MMA
#undef PG8_WAIT_V
#undef PG8_WAIT_L
#undef PG8_BAR
#undef PG8_SCHED
}
}

constexpr int DM = 2048, NB = 8, SEQ = 4096, CTXL = 256, DEPTH = 4, DFF = 8192, NMOD = 6 * DM;
constexpr int ML = NB * SEQ, MC = NB * CTXL, MT = ML + MC;
constexpr int ML_NSRC = 6176, ML_NPAD = 6400;
constexpr int NWAVES = 8;
constexpr float RMS_EPS = 1e-6f, LOG2E = 1.4426950408889634f;
constexpr size_t MiB = 1u << 20;
constexpr size_t WS_CTL = 0, CTL_ZERO_BYTES = 1 * MiB;
constexpr size_t WS_MODS = 1 * MiB;
constexpr size_t WS_ROPE = 3 * MiB;
constexpr size_t WS_PART = 4 * MiB;
constexpr size_t WS_HC = 60 * MiB;
constexpr size_t WS_WML_IN = 76 * MiB, WS_WML_OUT = 126 * MiB, WS_WNA_QKV = 142 * MiB, WS_WNA_OUT = 190 * MiB, WS_W1 = 206 * MiB, WS_W2 = 334 * MiB;
constexpr size_t WS_U = 462 * MiB;
constexpr size_t WS_P = 598 * MiB;
constexpr size_t WS_MQ = WS_P, WS_MK = WS_P + 68 * MiB, WS_MV = WS_P + 136 * MiB, WS_MOG = WS_P + 272 * MiB, WS_MG = WS_P + 408 * MiB, WS_HF = WS_P + 413 * MiB, WS_HB = WS_P + 549 * MiB;
constexpr size_t WS_QKV = WS_P;
constexpr size_t WS_HID = WS_P;
constexpr size_t WS_END = WS_P + 685 * MiB;
static_assert(WS_HID + (size_t)MT * DFF * 2 <= WS_END && WS_QKV + (size_t)MT * 6144 * 2 <= WS_END && WS_MG + (size_t)MT * 32 * 4 <= WS_HF && WS_HB + (size_t)MT * DM * 2 <= WS_END, "d_ws map");
constexpr int CW_TMO = 0, CW_BAR = 4096;
constexpr int RING_BYTES = 131072, LDSCTL_OFF = RING_BYTES, MISC_OFF = LDSCTL_OFF + 320, LDS_BYTES = 147456;

#define GAS __attribute__((address_space(1)))
#define LAS __attribute__((address_space(3)))
typedef unsigned short bf16;
typedef unsigned v4u __attribute__((ext_vector_type(4)));
typedef float f32x4 __attribute__((ext_vector_type(4)));
typedef short bf16x8 __attribute__((ext_vector_type(8)));
typedef GAS unsigned gu32;
typedef GAS unsigned long long gu64;
#define RLX_AGENT __ATOMIC_RELAXED, __HIP_MEMORY_SCOPE_AGENT
#define LDS_WAIT() asm volatile("s_waitcnt lgkmcnt(0)" ::: "memory")
#define VM_WAIT() asm volatile("s_waitcnt vmcnt(0)" ::: "memory")
__device__ __forceinline__ unsigned long long rt() { return __builtin_amdgcn_s_memrealtime(); }
__device__ __forceinline__ unsigned f2bf(float f) { unsigned u = __builtin_bit_cast(unsigned, f); return (u + 0x7fffu + ((u >> 16) & 1u)) >> 16; }
__device__ __forceinline__ unsigned pk2(float lo, float hi) { return f2bf(lo) | (f2bf(hi) << 16); }

#define XB_TMO      128
#define XB_XCNT(j)  (256  + 64 * (j))
#define XB_XSUB(j)  (1280 + 64 * (j))
#define XB_XGEN(j)  (2304 + 64 * (j))
#define XB_TOP      3328
#define XB_TOPGEN   3392
#define XCD_BAR_WORDS 3456
#define XB_SPIN_CAP (1u << 18)

__device__ __forceinline__ unsigned xb_ld(unsigned* p)              { return __hip_atomic_load(p, __ATOMIC_RELAXED, __HIP_MEMORY_SCOPE_AGENT); }
__device__ __forceinline__ unsigned xb_add(unsigned* p, unsigned v) { return __hip_atomic_fetch_add(p, v, __ATOMIC_RELAXED, __HIP_MEMORY_SCOPE_AGENT); }
__device__ __forceinline__ unsigned xb_xcc_id() { return (unsigned)__builtin_amdgcn_s_getreg((3 << 11) | 20) & 0xFu; }
#define XB_SPIN(cond, bar) do { unsigned _sp = 0; while (cond) { __builtin_amdgcn_s_sleep(1); \
    if ((++_sp & 255u) == 0u) { if (xb_ld(&(bar)[XB_TMO])) break; if (_sp > XB_SPIN_CAP) { atomicAdd(&(bar)[XB_TMO], 1u); break; } } } } while (0)

struct XcdBarrier {
    unsigned* bar; unsigned x;
    volatile LAS unsigned* st;
};

__device__ __forceinline__ XcdBarrier xcd_barrier_post(unsigned* bar, volatile LAS unsigned* st) {
    XcdBarrier b; b.bar = bar; b.x = xb_xcc_id(); b.st = st;
    if (threadIdx.x == 0) (void)xb_add(&bar[XB_XCNT(b.x)], 1u);
    return b;
}
__device__ __forceinline__ void xcd_barrier_complete(unsigned* bar, unsigned x, unsigned& nloc, unsigned& nx) {
    const unsigned G = gridDim.x * gridDim.y * gridDim.z;
    unsigned sum, cnt, mine, sp = 0u;
    for (;;) {
        sum = 0u; cnt = 0u; mine = 0u;
#pragma unroll
        for (unsigned j = 0; j < 16; ++j) { const unsigned c = xb_ld(&bar[XB_XCNT(j)]); sum += c; cnt += (c > 0u) ? 1u : 0u; mine = (j == x) ? c : mine; }
        if (sum == G) break;
        __builtin_amdgcn_s_sleep(1);
        if ((++sp & 255u) == 0u) { if (xb_ld(&bar[XB_TMO])) break; if (sp > XB_SPIN_CAP) { atomicAdd(&bar[XB_TMO], 1u); break; } }
    }
    nloc = mine > 0u ? mine : 1u; nx = cnt > 0u ? cnt : 1u;
}

__device__ __forceinline__ void xcd_barrier(const XcdBarrier& b) {
    asm volatile("s_waitcnt vmcnt(0)" ::: "memory");
    __syncthreads();
    if (threadIdx.x == 0) {
        unsigned* bar = b.bar;
        __builtin_amdgcn_s_waitcnt(0);
        unsigned nloc = b.st[0], nx = b.st[1];
        if (nloc == 0u) { xcd_barrier_complete(bar, b.x, nloc, nx); b.st[0] = nloc; b.st[1] = nx; }
        const unsigned old = xb_add(&bar[XB_XSUB(b.x)], 1u);
        const unsigned gen = old / nloc;
        if (old + 1u == (gen + 1u) * nloc) {
            __builtin_amdgcn_fence(__ATOMIC_RELEASE, "agent");
            asm volatile("s_waitcnt vmcnt(0)" ::: "memory");
            const unsigned og = xb_add(&bar[XB_TOP], 1u);
            const unsigned tg = og / nx;
            if (og + 1u == (tg + 1u) * nx) xb_add(&bar[XB_TOPGEN], 1u);
            else XB_SPIN(xb_ld(&bar[XB_TOPGEN]) == tg, bar);
            __builtin_amdgcn_fence(__ATOMIC_ACQUIRE, "agent");
            xb_add(&bar[XB_XGEN(b.x)], 1u);
            asm volatile("s_waitcnt vmcnt(0)" ::: "memory");
        } else {
            XB_SPIN(xb_ld(&bar[XB_XGEN(b.x)]) == gen, bar);
            __builtin_amdgcn_fence(__ATOMIC_ACQUIRE, "agent");
            asm volatile("s_waitcnt vmcnt(0)" ::: "memory");
        }
    }
    __syncthreads();
}

#define DI __device__ __forceinline__
typedef unsigned u32x4v __attribute__((ext_vector_type(4)));
typedef unsigned u32x2v __attribute__((ext_vector_type(2)));
typedef short s16x4 __attribute__((ext_vector_type(4)));
typedef short v4i16_t __attribute__((ext_vector_type(4)));
struct Args { const float* in[18]; float* out; unsigned char* ws; int ph_lo, ph_hi; };
enum { I_X = 0, I_C, I_CTX, I_CCTX, I_ADAW, I_ADAB, I_NMIX, I_NMLP, I_MLWIN, I_MLBG, I_MLNORM, I_MLWOUT, I_NAWQKV, I_NARPB, I_NAWOUT, I_W1, I_W2, I_FNORM };
struct Frame {
    LAS unsigned char* lds; int tid, lane, wave, G;
    float* out; unsigned char* ws;
};
DI float wave_sum(float v) {
#pragma unroll
    for (int o = 1; o < 64; o <<= 1) v += __shfl_xor(v, o);
    return v;
}
DI unsigned pkbf(float lo, float hi) { return pg8::cvt_pk_bf16(lo, hi); }
DI float bf_lo(unsigned w) { return __builtin_bit_cast(float, w << 16); }
DI float bf_hi(unsigned w) { return __builtin_bit_cast(float, w & 0xffff0000u); }
DI float ex2(float x) { return __builtin_amdgcn_exp2f(x); }
DI f32x4 mfma16(bf16x8 a, bf16x8 b, f32x4 c) { return __builtin_amdgcn_mfma_f32_16x16x32_bf16(a, b, c, 0, 0, 0); }
DI s16x4 tr_read(LAS unsigned char* p) { return __builtin_bit_cast(s16x4, __builtin_amdgcn_ds_read_tr16_b64_v4i16((LAS v4i16_t*)p)); }
DI bf16x8 cat8(s16x4 lo, s16x4 hi) { return __builtin_shufflevector(lo, hi, 0, 1, 2, 3, 4, 5, 6, 7); }

template <int MODE> DI void p0_transpose_item(const float* W, int K, int Nsrc, bf16* WT, int nblk, LAS float* scr, int item, int lane) {
    const int kb = item / nblk, nb = item % nblk, k0 = 64 * kb, n0 = 32 * nb;
    int nsrc = n0 + (lane & 31); bool valid = true;
    if (MODE == 1) { if (n0 < 2048) { const int p = nsrc & 127, pp = p & 63; nsrc = (nsrc & ~127) + (p & 64) + (pp >> 1) + 32 * (pp & 1); } valid = n0 < Nsrc; }
#pragma unroll 8
    for (int i = 0; i < 32; ++i) { const int kk = 2 * i + (lane >> 5); scr[kk * 33 + (lane & 31)] = valid ? W[(size_t)(k0 + kk) * Nsrc + nsrc] : 0.f; }
    LDS_WAIT(); asm volatile("" ::: "memory");
    const int c = lane & 7;
#pragma unroll
    for (int j = 0; j < 4; ++j) { const int n = (lane >> 3) + 8 * j; const LAS float* s = scr + (8 * c) * 33 + n;
        v4u o; o.x = pkbf(s[0 * 33], s[1 * 33]); o.y = pkbf(s[2 * 33], s[3 * 33]); o.z = pkbf(s[4 * 33], s[5 * 33]); o.w = pkbf(s[6 * 33], s[7 * 33]);
        *(GAS v4u*)(WT + (size_t)(n0 + n) * K + k0 + 8 * c) = o; }
    LDS_WAIT(); asm volatile("" ::: "memory");
}
DI void sincos_d(double ang, float& co, float& si) {
    const double TWO_PI = 6.283185307179586476925286766559;
    const double r = ang - TWO_PI * __builtin_rint(ang / TWO_PI), r2 = r * r;
    double s = 1.0, c = 1.0;
#pragma unroll
    for (int k = 14; k >= 1; --k) { s = 1.0 - s * r2 / (double)((2 * k) * (2 * k + 1)); c = 1.0 - c * r2 / (double)((2 * k - 1) * (2 * k)); }
    co = (float)c; si = (float)(s * r);
}
DI void p0_prologue(Frame& F, const Args& A) {
    const int gw = blockIdx.x * NWAVES + F.wave, NGW = F.G * NWAVES;
    { const int id = blockIdx.x * 512 + F.tid; if (id < 2048) { const int pos = id >> 5, j = id & 31; double iv = 1.0; for (int t = 0; t < j; ++t) iv *= 0.74989420933245582730; const float ang = (float)pos * (float)iv; float co, si; sincos_d((double)ang, co, si);
        float* R = (float*)(F.ws + WS_ROPE); R[2 * id] = co; R[2 * id + 1] = si; } }
    LAS float* scr = (LAS float*)(F.lds + F.wave * 8704);
    constexpr int T_MLIN = 32 * 200, T_SQ = 32 * 64, T_QKV = 32 * 192, T_W1 = 32 * 256, T_W2 = 128 * 64;
    constexpr int NITEMS = 2 * T_MLIN + 2 * T_SQ + 2 * T_QKV + 2 * T_SQ + 4 * T_W1 + 4 * T_W2;
    for (int it = gw; it < NITEMS; it += NGW) {
        int r = it;
        if (r < 2 * T_MLIN) { const int j = r / T_MLIN; p0_transpose_item<1>(A.in[I_MLWIN] + (size_t)j * DM * ML_NSRC, DM, ML_NSRC, (bf16*)(F.ws + WS_WML_IN) + (size_t)j * ML_NPAD * DM, 200, scr, r % T_MLIN, F.lane); continue; } r -= 2 * T_MLIN;
        if (r < 2 * T_SQ) { const int j = r / T_SQ; p0_transpose_item<0>(A.in[I_MLWOUT] + (size_t)j * DM * DM, DM, DM, (bf16*)(F.ws + WS_WML_OUT) + (size_t)j * DM * DM, 64, scr, r % T_SQ, F.lane); continue; } r -= 2 * T_SQ;
        if (r < 2 * T_QKV) { const int j = r / T_QKV; p0_transpose_item<0>(A.in[I_NAWQKV] + (size_t)j * DM * 6144, DM, 6144, (bf16*)(F.ws + WS_WNA_QKV) + (size_t)j * 6144 * DM, 192, scr, r % T_QKV, F.lane); continue; } r -= 2 * T_QKV;
        if (r < 2 * T_SQ) { const int j = r / T_SQ; p0_transpose_item<0>(A.in[I_NAWOUT] + (size_t)j * DM * DM, DM, DM, (bf16*)(F.ws + WS_WNA_OUT) + (size_t)j * DM * DM, 64, scr, r % T_SQ, F.lane); continue; } r -= 2 * T_SQ;
        if (r < 4 * T_W1) { const int j = r / T_W1; p0_transpose_item<0>(A.in[I_W1] + (size_t)j * DM * DFF, DM, DFF, (bf16*)(F.ws + WS_W1) + (size_t)j * DFF * DM, 256, scr, r % T_W1, F.lane); continue; } r -= 4 * T_W1;
        { const int j = r / T_W2; p0_transpose_item<0>(A.in[I_W2] + (size_t)j * DFF * DM, DFF, DM, (bf16*)(F.ws + WS_W2) + (size_t)j * DM * DFF, 64, scr, r % T_W2, F.lane); }
    }
    __syncthreads();
    LAS float* condT = (LAS float*)F.lds;
    for (int idx = F.tid; idx < 9 * DM; idx += 512) { const int r = idx / DM, k = idx % DM; const float v = r < 8 ? A.in[I_C][r * DM + k] : A.in[I_CCTX][k]; condT[k * 12 + r] = v / (1.f + __expf(-v)); }
    __syncthreads();
    float* PART = (float*)(F.ws + WS_PART);
    for (int it = gw; it < 4 * 48 * 32; it += NGW) {
        const int layer = it / 1536, rem = it % 1536, cc = rem >> 5, kc = rem & 31;
        const float* wp = A.in[I_ADAW] + ((size_t)layer * DM + kc * 64) * NMOD + cc * 256 + 4 * F.lane;
        f32x4 acc[9];
#pragma unroll
        for (int r = 0; r < 9; ++r) acc[r] = (f32x4){0.f, 0.f, 0.f, 0.f};
#pragma unroll 8
        for (int k = 0; k < 64; ++k) {
            const f32x4 w = *(const GAS f32x4*)(wp + (size_t)k * NMOD);
            const LAS f32x4* cp = (const LAS f32x4*)(condT + (kc * 64 + k) * 12); const f32x4 c0 = cp[0], c1 = cp[1], c2 = cp[2];
            acc[0] += w * c0[0]; acc[1] += w * c0[1]; acc[2] += w * c0[2]; acc[3] += w * c0[3];
            acc[4] += w * c1[0]; acc[5] += w * c1[1]; acc[6] += w * c1[2]; acc[7] += w * c1[3]; acc[8] += w * c2[0];
        }
#pragma unroll
        for (int r = 0; r < 9; ++r) *(GAS f32x4*)(PART + (((size_t)kc * 4 + layer) * 9 + r) * NMOD + cc * 256 + 4 * F.lane) = acc[r];
    }
}
DI void p1_mods(Frame& F, const Args& A) {
    const float* PART = (const float*)(F.ws + WS_PART); float* MODS = (float*)(F.ws + WS_MODS);
    for (int i = blockIdx.x * 512 + F.tid; i < 4 * 9 * NMOD / 4; i += F.G * 512) {
        const int e = i * 4, l = e / (9 * NMOD), c = e % NMOD;
        f32x4 s = *(const GAS f32x4*)(A.in[I_ADAB] + l * NMOD + c);
        for (int kc = 0; kc < 32; ++kc) s += *(const GAS f32x4*)(PART + (size_t)kc * 4 * 9 * NMOD + e);
        *(GAS f32x4*)(MODS + e) = s;
    }
}
template <bool COPY> DI void norm_phase(Frame& F, const float* src_lat, const float* src_ctx, const float* gain, const float* mods, int sc_off, int sh_off, int nrows) {
    bf16* U = (bf16*)(F.ws + WS_U); float* HC = (float*)(F.ws + WS_HC);
    const int rpw = nrows / F.G, rbase = blockIdx.x * rpw;
    f32x4 A[8], S[8]; int cur = -1;
    for (int i = F.wave; i < rpw; i += NWAVES) {
        const int row = rbase + i; const bool isc = row >= ML; const int bidx = isc ? 8 : (row >> 12);
        if (bidx != cur) { cur = bidx; const float* mp = mods + bidx * NMOD;
#pragma unroll
            for (int k = 0; k < 8; ++k) { const int c = 4 * F.lane + 256 * k; const f32x4 g = *(const GAS f32x4*)(gain + c), sc = *(const GAS f32x4*)(mp + sc_off + c); A[k] = g * (sc + 1.f); S[k] = *(const GAS f32x4*)(mp + sh_off + c); } }
        const float* xr = isc ? src_ctx + (size_t)(row - ML) * DM : src_lat + (size_t)row * DM;
        f32x4 v[8]; float ss = 0.f;
#pragma unroll
        for (int k = 0; k < 8; ++k) { v[k] = *(const GAS f32x4*)(xr + 4 * F.lane + 256 * k); ss += (v[k].x * v[k].x + v[k].y * v[k].y) + (v[k].z * v[k].z + v[k].w * v[k].w); }
        const float rstd = 1.f / sqrtf(wave_sum(ss) * (1.f / DM) + RMS_EPS);
        if (COPY) { float* dr = isc ? HC + (size_t)(row - ML) * DM : F.out + (size_t)row * DM;
#pragma unroll
            for (int k = 0; k < 8; ++k) *(GAS f32x4*)(dr + 4 * F.lane + 256 * k) = v[k]; }
        bf16* ur = U + (size_t)row * DM;
#pragma unroll
        for (int k = 0; k < 8; ++k) { const f32x4 o = v[k] * rstd * A[k] + S[k]; u32x2v w; w.x = pkbf(o.x, o.y); w.y = pkbf(o.z, o.w); *(GAS u32x2v*)(ur + 4 * F.lane + 256 * k) = w; }
    }
}
DI void final_norm_phase(Frame& F, const Args& AR) {
    const int rpw = ML / F.G, rbase = blockIdx.x * rpw;
    f32x4 A[8];
#pragma unroll
    for (int k = 0; k < 8; ++k) A[k] = *(const GAS f32x4*)(AR.in[I_FNORM] + 4 * F.lane + 256 * k);
    for (int i = F.wave; i < rpw; i += NWAVES) {
        float* xr = F.out + (size_t)(rbase + i) * DM; f32x4 v[8]; float ss = 0.f;
#pragma unroll
        for (int k = 0; k < 8; ++k) { v[k] = *(const GAS f32x4*)(xr + 4 * F.lane + 256 * k); ss += (v[k].x * v[k].x + v[k].y * v[k].y) + (v[k].z * v[k].z + v[k].w * v[k].w); }
        const float rstd = 1.f / sqrtf(wave_sum(ss) * (1.f / DM) + RMS_EPS);
#pragma unroll
        for (int k = 0; k < 8; ++k) *(GAS f32x4*)(xr + 4 * F.lane + 256 * k) = v[k] * rstd * A[k];
    }
}
DI void readout_phase(Frame& F, const float* mlnorm) {
    const bf16* HF = (const bf16*)(F.ws + WS_HF); const bf16* HB = (const bf16*)(F.ws + WS_HB); const bf16* OG = (const bf16*)(F.ws + WS_MOG); bf16* U = (bf16*)(F.ws + WS_U);
    const int gw = blockIdx.x * NWAVES + F.wave, NGW = F.G * NWAVES;
    for (int row = gw; row < MT; row += NGW) {
        const size_t ro = (size_t)row * DM;
#pragma unroll
        for (int k = 0; k < 4; ++k) {
            const int c = 8 * F.lane + 512 * k;
            const u32x4v a = *(const GAS u32x4v*)(HF + ro + c), b = *(const GAS u32x4v*)(HB + ro + c), g = *(const GAS u32x4v*)(OG + ro + c);
            const f32x4 n0 = *(const GAS f32x4*)(mlnorm + c), n1 = *(const GAS f32x4*)(mlnorm + c + 4);
            float h[8]; float ss = 0.f;
#pragma unroll
            for (int j = 0; j < 4; ++j) { h[2 * j] = bf_lo(a[j]) + bf_lo(b[j]); h[2 * j + 1] = bf_hi(a[j]) + bf_hi(b[j]); ss += h[2 * j] * h[2 * j] + h[2 * j + 1] * h[2 * j + 1]; }
#pragma unroll
            for (int o = 1; o < 32; o <<= 1) ss += __shfl_xor(ss, o);
            const float rstd = 1.f / sqrtf(ss * (1.f / 256.f) + RMS_EPS);
            u32x4v w;
#pragma unroll
            for (int j = 0; j < 4; ++j) { const float nlo = j < 2 ? n0[2 * j] : n1[2 * j - 4], nhi = j < 2 ? n0[2 * j + 1] : n1[2 * j - 3];
                w[j] = pkbf(h[2 * j] * rstd * nlo * bf_lo(g[j]), h[2 * j + 1] * rstd * nhi * bf_hi(g[j])); }
            *(GAS u32x4v*)(U + ro + c) = w;
        }
    }
}

constexpr int NA_PITCH = 272, NA_TILE = 64 * NA_PITCH, NA_RPB_OFF = 4 * NA_TILE;
DI void na_phase(Frame& F, const float* rpb, bool need_ctx) {
    const bf16* QKV = (const bf16*)(F.ws + WS_QKV); bf16* AO = (bf16*)(F.ws + WS_U);
    const int w = F.wave, lane = F.lane, fr = lane & 15, g = lane >> 4, tq = (lane >> 2) & 3, tp = lane & 3;
    LAS float* rpbs = (LAS float*)(F.lds + NA_RPB_OFF);
    const int nunits = 4096 + (need_ctx ? 256 : 0);
    for (int u = blockIdx.x; u < nunits; u += F.G) {
        int b, h, ntw, band_lo = 0, qrow = 0, c = 0, rs_w = 0, cs = 0, cstart = 0; size_t qg;
        if (u < 4096) { const int x = u & 7, rp = (u >> 3) & 31, y = u >> 8, bh = y * 8 + x; b = bh >> 4; h = bh & 15;
            const int r0 = 2 * rp; qrow = r0 + (w >> 2); const int cb = w & 3; c = 16 * cb + fr; qg = (size_t)b * SEQ + qrow * 64 + c;
            rs_w = min(max(qrow - 4, 0), 56); band_lo = min(max(r0 - 4, 0), 56); const int band_hi = min(max(r0 - 3, 0), 56) + 7; ntw = band_hi - band_lo + 1;
            cstart = min(max(c - 8, 0), 48); cs = cb == 0 ? 0 : (cb == 1 ? 8 : (cb == 2 ? 24 : 32));
        } else { const int uc = u - 4096; b = uc >> 5; h = (uc >> 1) & 15; qg = (size_t)ML + b * CTXL + 128 * (uc & 1) + 16 * w + fr; ntw = 0; }
        const int NT = ntw + 4;
        bf16x8 qf[4];
#pragma unroll
        for (int ks = 0; ks < 4; ++ks) qf[ks] = *(const GAS bf16x8*)(QKV + qg * 6144 + h * 128 + 32 * ks + 8 * g);
        if (ntw) for (int i = F.tid; i < 465; i += 512) rpbs[i] = rpb[h * 465 + i];
        f32x4 o[8];
#pragma unroll
        for (int d = 0; d < 8; ++d) o[d] = (f32x4){0.f, 0.f, 0.f, 0.f};
        float m_run = -INFINITY, l_run = 0.f;
        u32x4v pk[2], pv[2];
        { const size_t base = ntw ? (size_t)b * SEQ + band_lo * 64 : (size_t)ML + b * CTXL;
#pragma unroll
          for (int i = 0; i < 2; ++i) { const int id = F.tid + 512 * i, row = id >> 4, off = id & 15; const bf16* p = QKV + (base + row) * 6144 + 2048 + h * 128 + off * 8;
              pk[i] = *(const GAS u32x4v*)p; pv[i] = *(const GAS u32x4v*)(p + 2048); }
#pragma unroll
          for (int i = 0; i < 2; ++i) { const int id = F.tid + 512 * i, row = id >> 4, off = id & 15;
              *(LAS u32x4v*)(F.lds + row * NA_PITCH + off * 16) = pk[i]; *(LAS u32x4v*)(F.lds + NA_TILE + row * NA_PITCH + off * 16) = pv[i]; } }
        __syncthreads();
        for (int t = 0; t < NT; ++t) {
            LAS unsigned char* Kb = F.lds + (t & 1) * 2 * NA_TILE; LAS unsigned char* Vb = Kb + NA_TILE;
            if (t + 1 < NT) { const int t1 = t + 1; const size_t base = t1 < ntw ? (size_t)b * SEQ + (band_lo + t1) * 64 : (size_t)ML + b * CTXL + 64 * (t1 - ntw);
#pragma unroll
                for (int i = 0; i < 2; ++i) { const int id = F.tid + 512 * i, row = id >> 4, off = id & 15; const bf16* p = QKV + (base + row) * 6144 + 2048 + h * 128 + off * 8;
                    pk[i] = *(const GAS u32x4v*)p; pv[i] = *(const GAS u32x4v*)(p + 2048); } }
            const bool win = t < ntw; const int kr = band_lo + t;
            const bool active = !win || (kr >= rs_w && kr <= rs_w + 7);
            if (active) {
                const int nstep = win ? 1 : 2; const int brow = (kr - qrow + 7) * 31;
                for (int st = 0; st < nstep; ++st) {
                    const int ko = win ? cs : 32 * st;
                    f32x4 s[2];
#pragma unroll
                    for (int kg = 0; kg < 2; ++kg) { s[kg] = (f32x4){0.f, 0.f, 0.f, 0.f};
#pragma unroll
                        for (int ks = 0; ks < 4; ++ks) { const bf16x8 kf = *(const LAS bf16x8*)(Kb + (ko + 16 * kg + fr) * NA_PITCH + (32 * ks + 8 * g) * 2); s[kg] = mfma16(kf, qf[ks], s[kg]); } }
                    float mx = -INFINITY;
#pragma unroll
                    for (int kg = 0; kg < 2; ++kg)
#pragma unroll
                        for (int i = 0; i < 4; ++i) { float v = s[kg][i];
                            if (win) { const int kc = ko + 16 * kg + 4 * g + i; const bool valid = kc >= cstart && kc < cstart + 16; const int bi = valid ? brow + (kc - c + 15) : 0;
                                v = valid ? (v + rpbs[bi]) * LOG2E : -INFINITY; }
                            else v *= LOG2E;
                            s[kg][i] = v; mx = fmaxf(mx, v); }
                    mx = fmaxf(mx, __shfl_xor(mx, 16)); mx = fmaxf(mx, __shfl_xor(mx, 32));
                    const float m_new = fmaxf(m_run, mx), alpha = ex2(m_run - m_new); m_run = m_new;
                    float ls = 0.f;
#pragma unroll
                    for (int kg = 0; kg < 2; ++kg)
#pragma unroll
                        for (int i = 0; i < 4; ++i) { const float p = ex2(s[kg][i] - m_new); s[kg][i] = p; ls += p; }
                    l_run = l_run * alpha + ls;
#pragma unroll
                    for (int d = 0; d < 8; ++d) o[d] = o[d] * alpha;
                    u32x4v pw; pw.x = pkbf(s[0][0], s[0][1]); pw.y = pkbf(s[0][2], s[0][3]); pw.z = pkbf(s[1][0], s[1][1]); pw.w = pkbf(s[1][2], s[1][3]);
                    const bf16x8 pb = __builtin_bit_cast(bf16x8, pw);
#pragma unroll
                    for (int d = 0; d < 8; ++d) {
                        const s16x4 lo = tr_read(Vb + (ko + 4 * g + tq) * NA_PITCH + 32 * d + 8 * tp), hi = tr_read(Vb + (ko + 16 + 4 * g + tq) * NA_PITCH + 32 * d + 8 * tp);
                        o[d] = mfma16(cat8(lo, hi), pb, o[d]); }
                }
            }
            if (t + 1 < NT) { LAS unsigned char* Kn = F.lds + ((t + 1) & 1) * 2 * NA_TILE;
#pragma unroll
                for (int i = 0; i < 2; ++i) { const int id = F.tid + 512 * i, row = id >> 4, off = id & 15;
                    *(LAS u32x4v*)(Kn + row * NA_PITCH + off * 16) = pk[i]; *(LAS u32x4v*)(Kn + NA_TILE + row * NA_PITCH + off * 16) = pv[i]; } }
            __syncthreads();
        }
        float l = l_run; l += __shfl_xor(l, 16); l += __shfl_xor(l, 32);
        const float inv = 1.f / l;
        bf16* op = AO + qg * DM + h * 128 + 4 * g;
#pragma unroll
        for (int d = 0; d < 8; ++d) { u32x2v wv; wv.x = pkbf(o[d][0] * inv, o[d][1] * inv); wv.y = pkbf(o[d][2] * inv, o[d][3] * inv); *(GAS u32x2v*)(op + 16 * d) = wv; }
    }
}

constexpr int SC_P = 272, SC_Q = 0, SC_K = 17408, SC_V = 34816, SC_H = 52224, SC_S = 69632, SC_SP = 144, SC_TB = 78848;
constexpr int SC_E2 = SC_TB, SC_M2 = SC_TB + 256, SC_WST = SC_TB + 512, SC_NMS = SC_TB + 768, SC_WK = SC_TB + 1024, SC_SCAL = SC_TB + 1280, SC_NF = SC_TB + 1536, SC_NBF = SC_NF + 512, SC_QN = SC_NBF + 256, SC_RS = SC_QN + 512;
DI void scan_phase(Frame& F) {
    const bf16* Qg = (const bf16*)(F.ws + WS_MQ); const bf16* Kg = (const bf16*)(F.ws + WS_MK); const bf16* Vg = (const bf16*)(F.ws + WS_MV); const float* Gg = (const float*)(F.ws + WS_MG);
    const int w = F.wave, lane = F.lane, fr = lane & 15, g = lane >> 4, tq = (lane >> 2) & 3, tp = lane & 3;
    LAS unsigned char* L = F.lds;
    for (int u = blockIdx.x; u < 256; u += F.G) {
        const int x = u & 7, y = u >> 3, eh = y & 1, pi = (y >> 1) * 8 + x, dir = pi & 1, bh = pi >> 1, b = bh >> 3, hd = bh & 7;
        bf16* Hg = (bf16*)(F.ws + (dir ? WS_HB : WS_HF));
        f32x4 C[8];
#pragma unroll
        for (int d = 0; d < 8; ++d) C[d] = (f32x4){0.f, 0.f, 0.f, 0.f};
        if (F.tid < 128) { ((LAS float*)(L + SC_NF))[F.tid] = 0.f; ((LAS unsigned short*)(L + SC_NBF))[F.tid] = 0; }
        float m_run = 0.f;
        u32x4v pq[2], pk[2], pv[2]; float g_i = 0.f, g_f = 0.f;
        for (int q = -1; q < 68; ++q) {
            const int qn = q + 1; size_t row1 = 0;
            if (qn < 68) { row1 = qn < 4 ? (size_t)ML + b * CTXL + 64 * (dir ? 3 - qn : qn) : (size_t)b * SEQ + 64 * (dir ? 63 - (qn - 4) : (qn - 4));
#pragma unroll
                for (int i = 0; i < 2; ++i) { const int id = F.tid + 512 * i, row = id >> 4, off = id & 15;
                    pq[i] = *(const GAS u32x4v*)(Qg + (row1 + row) * 1024 + hd * 128 + off * 8); pk[i] = *(const GAS u32x4v*)(Kg + (row1 + row) * 1024 + hd * 128 + off * 8);
                    pv[i] = *(const GAS u32x4v*)(Vg + (row1 + row) * 2048 + hd * 256 + eh * 128 + off * 8); }
                if (w == 0) { const int o = dir ? 63 - lane : lane; const float* gp = Gg + (row1 + o) * 32 + dir * 16 + hd; g_i = gp[0]; g_f = gp[8]; } }
            if (q >= 0) {
                const size_t row0 = q < 4 ? (size_t)ML + b * CTXL + 64 * (dir ? 3 - q : q) : (size_t)b * SEQ + 64 * (dir ? 63 - (q - 4) : (q - 4));
                const int st = w & 3, jh = w >> 2;
                bf16x8 qf[4];
#pragma unroll
                for (int ks = 0; ks < 4; ++ks) qf[ks] = *(const LAS bf16x8*)(L + SC_Q + (16 * st + fr) * SC_P + (32 * ks + 8 * g) * 2);
                const float Ms = ((const LAS float*)(L + SC_M2))[16 * st + fr];
#pragma unroll
                for (int jj = 0; jj < 2; ++jj) { const int jt = 2 * jh + jj; f32x4 a = (f32x4){0.f, 0.f, 0.f, 0.f};
#pragma unroll
                    for (int ks = 0; ks < 4; ++ks) { const bf16x8 kf = *(const LAS bf16x8*)(L + SC_K + (16 * jt + fr) * SC_P + (32 * ks + 8 * g) * 2); a = mfma16(kf, qf[ks], a); }
                    const f32x4 e4 = *(const LAS f32x4*)(L + SC_E2 + (16 * jt + 4 * g) * 4); float rs = 0.f;
#pragma unroll
                    for (int i = 0; i < 4; ++i) { const int j = 16 * jt + 4 * g + i, s = 16 * st + fr; const bool causal = dir ? (j >= s) : (j <= s);
                        const float wgt = causal ? ex2(e4[i] - Ms) : 0.f; a[i] = a[i] * wgt; rs += a[i]; }
                    rs += __shfl_xor(rs, 16); rs += __shfl_xor(rs, 32);
                    if (g == 0) ((LAS float*)(L + SC_RS))[jt * 64 + 16 * st + fr] = rs;
                    u32x2v sw; sw.x = pkbf(a[0], a[1]); sw.y = pkbf(a[2], a[3]);
                    *(LAS u32x2v*)(L + SC_S + (16 * st + fr) * SC_SP + (16 * jt + 4 * g) * 2) = sw; }
                { f32x4 a = (f32x4){0.f, 0.f, 0.f, 0.f};
#pragma unroll
                  for (int kk = 0; kk < 2; ++kk) { const int ks = 2 * jh + kk; const bf16x8 nf = *(const LAS bf16x8*)(L + SC_NBF + (32 * ks + 8 * g) * 2); a = mfma16(nf, qf[ks], a); }
                  if (g == 0) ((LAS float*)(L + SC_QN))[jh * 64 + 16 * st + fr] = a[0]; }
                __syncthreads();
                bf16x8 vf[2];
#pragma unroll
                for (int k2 = 0; k2 < 2; ++k2) { const s16x4 lo = tr_read(L + SC_V + (32 * k2 + 8 * g + tq) * SC_P + 32 * w + 8 * tp), hi = tr_read(L + SC_V + (32 * k2 + 8 * g + 4 + tq) * SC_P + 32 * w + 8 * tp); vf[k2] = cat8(lo, hi); }
                bf16x8 cb[4];
#pragma unroll
                for (int ks = 0; ks < 4; ++ks) { u32x4v cw; cw.x = pkbf(C[2 * ks][0], C[2 * ks][1]); cw.y = pkbf(C[2 * ks][2], C[2 * ks][3]); cw.z = pkbf(C[2 * ks + 1][0], C[2 * ks + 1][1]); cw.w = pkbf(C[2 * ks + 1][2], C[2 * ks + 1][3]); cb[ks] = __builtin_bit_cast(bf16x8, cw); }
#pragma unroll
                for (int s4 = 0; s4 < 4; ++s4) {
                    const int sb = 16 * s4 + 4 * g;
                    const f32x4 qn0 = *(const LAS f32x4*)(L + SC_QN + sb * 4), qn1 = *(const LAS f32x4*)(L + SC_QN + (64 + sb) * 4);
                    const f32x4 r0 = *(const LAS f32x4*)(L + SC_RS + sb * 4), r1 = *(const LAS f32x4*)(L + SC_RS + (64 + sb) * 4), r2 = *(const LAS f32x4*)(L + SC_RS + (128 + sb) * 4), r3 = *(const LAS f32x4*)(L + SC_RS + (192 + sb) * 4);
                    const f32x4 w4 = *(const LAS f32x4*)(L + SC_WST + sb * 4), nm = *(const LAS f32x4*)(L + SC_NMS + sb * 4);
                    f32x4 y = (f32x4){0.f, 0.f, 0.f, 0.f};
#pragma unroll
                    for (int ks = 0; ks < 4; ++ks) { const LAS unsigned char* qp = L + SC_Q + (16 * s4 + fr) * SC_P;
                        const u32x2v lo = *(const LAS u32x2v*)(qp + (32 * ks + 4 * g) * 2), hi = *(const LAS u32x2v*)(qp + (32 * ks + 16 + 4 * g) * 2);
                        u32x4v aw; aw.x = lo.x; aw.y = lo.y; aw.z = hi.x; aw.w = hi.y; y = mfma16(__builtin_bit_cast(bf16x8, aw), cb[ks], y); }
                    y = y * w4;
#pragma unroll
                    for (int k2 = 0; k2 < 2; ++k2) { const bf16x8 sf = *(const LAS bf16x8*)(L + SC_S + (16 * s4 + fr) * SC_SP + (32 * k2 + 8 * g) * 2); y = mfma16(sf, vf[k2], y); }
#pragma unroll
                    for (int i = 0; i < 4; ++i) { const float den = w4[i] * (qn0[i] + qn1[i]) + ((r0[i] + r1[i]) + (r2[i] + r3[i])); const float hv = y[i] / fmaxf(fabsf(den), ex2(nm[i]));
                        *(LAS unsigned short*)(L + SC_H + (sb + i) * SC_P + (16 * w + fr) * 2) = (unsigned short)(pkbf(hv, 0.f) & 0xffffu); }
                }
                const float decay = ((const LAS float*)(L + SC_SCAL))[0];
                bf16x8 vw[2], wkf[2];
#pragma unroll
                for (int k2 = 0; k2 < 2; ++k2) { const f32x4 wa = *(const LAS f32x4*)(L + SC_WK + (32 * k2 + 8 * g) * 4), wb = *(const LAS f32x4*)(L + SC_WK + (32 * k2 + 8 * g + 4) * 4);
                    const u32x4v vu = __builtin_bit_cast(u32x4v, vf[k2]); u32x4v o, ww;
                    o.x = pkbf(bf_lo(vu.x) * wa[0], bf_hi(vu.x) * wa[1]); o.y = pkbf(bf_lo(vu.y) * wa[2], bf_hi(vu.y) * wa[3]); o.z = pkbf(bf_lo(vu.z) * wb[0], bf_hi(vu.z) * wb[1]); o.w = pkbf(bf_lo(vu.w) * wb[2], bf_hi(vu.w) * wb[3]);
                    ww.x = pkbf(wa[0], wa[1]); ww.y = pkbf(wa[2], wa[3]); ww.z = pkbf(wb[0], wb[1]); ww.w = pkbf(wb[2], wb[3]);
                    vw[k2] = __builtin_bit_cast(bf16x8, o); wkf[k2] = __builtin_bit_cast(bf16x8, ww); }
                f32x4 nacc = (f32x4){0.f, 0.f, 0.f, 0.f};
#pragma unroll
                for (int d = 0; d < 8; ++d) { C[d] = C[d] * decay;
#pragma unroll
                    for (int k2 = 0; k2 < 2; ++k2) { const s16x4 lo = tr_read(L + SC_K + (32 * k2 + 8 * g + tq) * SC_P + 32 * d + 8 * tp), hi = tr_read(L + SC_K + (32 * k2 + 8 * g + 4 + tq) * SC_P + 32 * d + 8 * tp);
                        const bf16x8 kt = cat8(lo, hi); C[d] = mfma16(kt, vw[k2], C[d]); if (d == w) nacc = mfma16(kt, wkf[k2], nacc); } }
                if (fr == 0) { LAS float* nfp = (LAS float*)(L + SC_NF) + 16 * w + 4 * g; const f32x4 nold = *(LAS f32x4*)nfp; const f32x4 nn = nold * decay + nacc; *(LAS f32x4*)nfp = nn;
                    u32x2v nb; nb.x = pkbf(nn[0], nn[1]); nb.y = pkbf(nn[2], nn[3]); *(LAS u32x2v*)(L + SC_NBF + (16 * w + 4 * g) * 2) = nb; }
                __syncthreads();
#pragma unroll
                for (int i = 0; i < 2; ++i) { const int id = F.tid + 512 * i, row = id >> 4, off = id & 15;
                    *(GAS u32x4v*)(Hg + (row0 + row) * DM + hd * 256 + eh * 128 + off * 8) = *(const LAS u32x4v*)(L + SC_H + row * SC_P + off * 16); }
            }
            if (qn < 68) {
#pragma unroll
                for (int i = 0; i < 2; ++i) { const int id = F.tid + 512 * i, row = id >> 4, off = id & 15;
                    *(LAS u32x4v*)(L + SC_Q + row * SC_P + off * 16) = pq[i]; *(LAS u32x4v*)(L + SC_K + row * SC_P + off * 16) = pk[i]; *(LAS u32x4v*)(L + SC_V + row * SC_P + off * 16) = pv[i]; }
                if (w == 0) {
                    const int o = dir ? 63 - lane : lane;
                    float bcs = g_f;
#pragma unroll
                    for (int d = 1; d < 64; d <<= 1) { const float t = __shfl_up(bcs, d); if (lane >= d) bcs += t; }
                    const float e = g_i - bcs; float pm = e;
#pragma unroll
                    for (int d = 1; d < 64; d <<= 1) { const float t = __shfl_up(pm, d); if (lane >= d) pm = fmaxf(pm, t); }
                    const float M = fmaxf(m_run, pm), Mlast = __shfl(M, 63), btot = __shfl(bcs, 63);
                    ((LAS float*)(L + SC_E2))[o] = e * LOG2E; ((LAS float*)(L + SC_M2))[o] = M * LOG2E; ((LAS float*)(L + SC_WST))[o] = __expf(m_run - M);
                    ((LAS float*)(L + SC_NMS))[o] = -(bcs + M) * LOG2E; ((LAS float*)(L + SC_WK))[o] = __expf(e - Mlast);
                    if (lane == 0) ((LAS float*)(L + SC_SCAL))[0] = __expf(m_run - Mlast);
                    m_run = btot + Mlast;
                }
            }
            __syncthreads();
        }
    }
}

constexpr int N_PHASES = 2 + 8 * DEPTH + 1;
#ifndef DBG_DEPTH
#define DBG_DEPTH DEPTH
#endif
__global__ void __launch_bounds__(NWAVES * 64, 2) fwd(Args args) {
    extern __shared__ __attribute__((aligned(16))) unsigned char lds[];
    Frame F;
    F.lds = (LAS unsigned char*)lds; F.tid = threadIdx.x; F.lane = F.tid & 63; F.wave = __builtin_amdgcn_readfirstlane(F.tid >> 6); F.G = gridDim.x;
    F.out = args.out; F.ws = args.ws;
    volatile LAS unsigned* MISC = (volatile LAS unsigned*)(F.lds + MISC_OFF);
    for (int u = F.tid; u < (LDS_BYTES - LDSCTL_OFF) / 4; u += NWAVES * 64) ((LAS unsigned*)(F.lds + LDSCTL_OFF))[u] = 0u;
    __syncthreads();
    const int lo = args.ph_lo, hi = args.ph_hi;
    unsigned* barw = (unsigned*)(F.ws + WS_CTL) + CW_BAR;
    XcdBarrier bar; bar.bar = barw; bar.x = 0; bar.st = nullptr;
    if (hi - lo > 1) bar = xcd_barrier_post(barw, MISC + 8);
#define FRESH() do { int t_ = threadIdx.x; asm volatile("" : "+v"(t_)); F.tid = t_; F.lane = t_ & 63; F.wave = __builtin_amdgcn_readfirstlane(t_ >> 6); \
    unsigned char* w_ = args.ws; asm volatile("" : "+s"(w_)); F.ws = w_; float* o_ = args.out; asm volatile("" : "+s"(o_)); F.out = o_; } while (0)
#define RUN(k) (lo <= (k) && (k) < hi)
#define SEAM(k) do { if (RUN(k) && RUN((k) + 1)) xcd_barrier(bar); } while (0)
    LAS unsigned char* ring = F.lds;
#define U ((bf16*)(F.ws + WS_U))
#define HC ((float*)(F.ws + WS_HC))
#define MODS ((const float*)(F.ws + WS_MODS))

    #ifndef NO_P0
    if (RUN(0)) { FRESH(); p0_prologue(F, args); }
#endif
    SEAM(0);
    if (RUN(1)) { FRESH(); p1_mods(F, args); } SEAM(1);

    for (int layer = 0; layer < DBG_DEPTH; ++layer) {
        const int pb = 2 + 8 * layer, j = layer >> 1; const bool is_na = (layer & 1) != 0, need_ctx = layer < DEPTH - 1;
        const int mrows = need_ctx ? MT : ML;
#define mods (MODS + (size_t)layer * 9 * NMOD)
        if (RUN(pb + 0)) { FRESH(); if (layer == 0) norm_phase<true>(F, args.in[I_X], args.in[I_CTX], args.in[I_NMIX], mods, DM, 0, MT); else norm_phase<false>(F, F.out, HC, args.in[I_NMIX] + layer * DM, mods, DM, 0, MT); }
        SEAM(pb + 0);
        if (RUN(pb + 1)) { FRESH();
            if (!is_na) {
                pg8::Gemm g{U, (const bf16*)(F.ws + WS_WML_IN) + (size_t)j * ML_NPAD * DM, MT, ML_NPAD, DM}; pg8::Order8 S; S.init(MT, ML_NPAD, F.G, (int)blockIdx.x);
                pg8::EpiMl E{(bf16*)(F.ws + WS_MQ), (bf16*)(F.ws + WS_MK), (bf16*)(F.ws + WS_MV), (bf16*)(F.ws + WS_MOG), (float*)(F.ws + WS_MG), args.in[I_MLBG] + j * 32, (const float*)(F.ws + WS_ROPE)};
#ifndef NO_G1
                pg8::gemm_phase<pg8::EpiMl, pg8::Order8, true, true>(ring, g, S, E, F.tid);
#endif
            } else {
                pg8::Gemm g{U, (const bf16*)(F.ws + WS_WNA_QKV) + (size_t)j * 6144 * DM, MT, 6144, DM}; pg8::Order8 S; S.init(MT, 6144, F.G, (int)blockIdx.x);
                pg8::EpiQKV E{(bf16*)(F.ws + WS_QKV), 6144, 8, 0.08838834764831845f};
#ifndef NO_G2
                pg8::gemm_phase<pg8::EpiQKV, pg8::Order8, true, true>(ring, g, S, E, F.tid);
#endif
            }
        }
        SEAM(pb + 1);
        if (RUN(pb + 2)) { FRESH();
#ifndef NO_SCAN
            if (!is_na) scan_phase(F);
#endif
#ifndef NO_NA
            if (is_na) na_phase(F, args.in[I_NARPB] + (size_t)j * 16 * 465, need_ctx);
#endif
        }
        SEAM(pb + 2);
        if (RUN(pb + 3)) { FRESH(); if (!is_na) readout_phase(F, args.in[I_MLNORM] + j * DM); }
        if (!is_na) SEAM(pb + 3);
        if (RUN(pb + 4)) { FRESH();
            const bf16* wt = is_na ? (const bf16*)(F.ws + WS_WNA_OUT) + (size_t)j * DM * DM : (const bf16*)(F.ws + WS_WML_OUT) + (size_t)j * DM * DM;
            pg8::Gemm g{U, wt, mrows, DM, DM}; pg8::Order8 S; S.init(mrows, DM, F.G, (int)blockIdx.x);
            pg8::EpiRes E{F.out, HC, mods, 2 * DM};
#ifndef NO_G3
            pg8::gemm_phase<pg8::EpiRes, pg8::Order8, true, true>(ring, g, S, E, F.tid);
#endif
        }
        SEAM(pb + 4);
        if (RUN(pb + 5)) { FRESH(); norm_phase<false>(F, F.out, HC, args.in[I_NMLP] + layer * DM, mods, 4 * DM, 3 * DM, mrows); }
        SEAM(pb + 5);
        if (RUN(pb + 6)) { FRESH();
            pg8::Gemm g{U, (const bf16*)(F.ws + WS_W1) + (size_t)layer * DFF * DM, mrows, DFF, DM}; pg8::Order8 S; S.init(mrows, DFF, F.G, (int)blockIdx.x);
            pg8::EpiSqRelu E{(bf16*)(F.ws + WS_HID), DFF};
#ifndef NO_G4
            pg8::gemm_phase<pg8::EpiSqRelu, pg8::Order8, true, true>(ring, g, S, E, F.tid);
#endif
        }
        SEAM(pb + 6);
        if (RUN(pb + 7)) { FRESH();
            pg8::Gemm g{(const bf16*)(F.ws + WS_HID), (const bf16*)(F.ws + WS_W2) + (size_t)layer * DM * DFF, mrows, DM, DFF}; pg8::Order8 S; S.init(mrows, DM, F.G, (int)blockIdx.x);
            pg8::EpiRes E{F.out, HC, mods, 5 * DM};
#ifndef NO_G5
            pg8::gemm_phase<pg8::EpiRes, pg8::Order8, true, true>(ring, g, S, E, F.tid);
#endif
        }
        SEAM(pb + 7);
    }
#undef mods
    if (RUN(N_PHASES - 1)) final_norm_phase(F, args);
#undef RUN
#undef U
#undef HC
#undef MODS
#undef FRESH
#undef SEAM
}

extern "C" void kernel_launch(void* const* d_in, const int* in_sizes, int n_in, void* d_out, int out_size, void* d_ws, size_t ws_size, hipStream_t stream) {
    static int grid = 0;
    if (grid == 0) {
        if (n_in != 18 || out_size != ML * DM || ws_size < WS_END) { fprintf(stderr, "kernel_launch: built for 18 inputs, out of %d floats, >= %zu bytes of workspace; got n_in %d, out %d, ws %zu; nothing launched\n", ML * DM, (size_t)WS_END, n_in, out_size, ws_size); grid = -1; return; }
        int dev = 0, cus = 0, per_cu = 0;
        if (hipGetDevice(&dev) != hipSuccess || hipDeviceGetAttribute(&cus, hipDeviceAttributeMultiprocessorCount, dev) != hipSuccess) { fprintf(stderr, "kernel_launch: device query failed\n"); grid = -1; return; }
        if (hipFuncSetAttribute((const void*)fwd, hipFuncAttributeMaxDynamicSharedMemorySize, LDS_BYTES) != hipSuccess) { fprintf(stderr, "kernel_launch: hipFuncSetAttribute failed\n"); grid = -1; return; }
        if (hipOccupancyMaxActiveBlocksPerMultiprocessor(&per_cu, (const void*)fwd, NWAVES * 64, LDS_BYTES) != hipSuccess || per_cu < 1) fprintf(stderr, "kernel_launch: note: occupancy query reports %d workgroups per CU\n", per_cu);
        (void)hipGetLastError();
        if (cus < 256) { fprintf(stderr, "kernel_launch: needs 256 CUs (one resident workgroup each), device has %d; nothing launched\n", cus); grid = -1; return; }
        grid = 256;
    }
    if (grid < 0) return;
    if (hipMemsetAsync((char*)d_ws + WS_CTL, 0, CTL_ZERO_BYTES, stream) != hipSuccess) { fprintf(stderr, "kernel_launch: hipMemsetAsync failed\n"); return; }
    Args a{};
    for (int i = 0; i < 18; ++i) a.in[i] = (const float*)d_in[i];
    a.out = (float*)d_out; a.ws = (unsigned char*)d_ws;
#if MK_PER_PHASE
    for (int p = 0; p < N_PHASES; ++p) { a.ph_lo = p; a.ph_hi = p + 1; hipLaunchKernelGGL(fwd, dim3(grid), dim3(NWAVES * 64), LDS_BYTES, stream, a); }
#else
    a.ph_lo = 0; a.ph_hi = N_PHASES;
    hipLaunchKernelGGL(fwd, dim3(grid), dim3(NWAVES * 64), LDS_BYTES, stream, a);
#endif
    const hipError_t le = hipPeekAtLastError();
    if (le != hipSuccess) fprintf(stderr, "kernel_launch: launch failed: %s\n", hipGetErrorName(le));
}
```

```cpp
#include <hip/hip_runtime.h>
#include <cstdio>
#include <cstdint>
#include <cmath>
#ifndef MK_PER_PHASE
#define MK_PER_PHASE 0
#endif
namespace pg8 {
#define PG8_LAS __attribute__((address_space(3)))
typedef unsigned short bf16_t;
typedef short bf16x8 __attribute__((ext_vector_type(8)));
typedef float f32x4 __attribute__((ext_vector_type(4)));
typedef unsigned u32x4 __attribute__((ext_vector_type(4)));
constexpr int BM = 256, BK = 64, HALF = 128, HTB = HALF * BK * 2  , STAGE_BYTES = 8 * HTB, NXCD = 8, WGM = 8;

__host__ __device__ __forceinline__ int lds_byte(int r, int c) { const int st = (r >> 4) * 2 + (c >> 5), rr = r & 15, cc = c & 31, ob = rr * 64 + cc * 2; return st * 1024 + (ob ^ (((ob >> 9) & 1) << 5)); }
__host__ __device__ __forceinline__ void stage_rc(int b, int& R, int& C) { const int st = b / 1024, sb = b % 1024, swz = sb ^ (((sb >> 9) & 1) << 5); R = (st >> 1) * 16 + swz / 64; C = (st & 1) * 32 + (swz % 64) / 2; }
__host__ __device__ __forceinline__ int perm32(int rho) { const int n = rho >> 4, i = rho & 15; return 8 * (i >> 2) + 4 * n + (i & 3); }

__host__ __device__ __forceinline__ size_t ablk_byte(int r, int c, int ld) { return ((size_t)(r >> 7) * (ld >> 6) + (c >> 6)) * HTB + lds_byte(r & 127, c & 63); }
__host__ __device__ __forceinline__ size_t bblk_byte(int n, int k, int ld) { const int nl = n & 127, x = nl & 31, rho = 16 * ((x >> 2) & 1) + 4 * (x >> 3) + (x & 3);
    return ((size_t)(n >> 7) * (ld >> 6) + (k >> 6)) * HTB + lds_byte((nl & ~31) + rho, k & 63); }
struct Unit { int pm, pn, kq; };
struct Gemm { const bf16_t* A; const bf16_t* Bt; int M, N, K, ld, ablk, bblk; };

struct StaticOrder {
    int nM, nN, nwg, G, c;
    __host__ __device__ void init(int M, int N, int G_, int c_) { nM = M / BM; nN = N / BM; nwg = nM * nN; G = G_; c = c_; }
    __host__ __device__ bool next(int i, Unit& u) const {
        const long L = (long)i * G + c; if (L >= nwg) return false;
        int wgid = (int)L; { const int q = nwg / NXCD, r = nwg % NXCD, xcd = wgid % NXCD, off = wgid / NXCD; wgid = (xcd < r ? xcd * (q + 1) : r * (q + 1) + (xcd - r) * q) + off; }
        const int nig = WGM * nN, gid = wgid / nig, fm = gid * WGM, gsz = (nM - fm) < WGM ? (nM - fm) : WGM;
        u.pm = fm + ((wgid % nig) % gsz); u.pn = (wgid % nig) / gsz; u.kq = 0; return true;
    }
    __device__ __forceinline__ void a_ready(const Unit&) const {}
    __device__ __forceinline__ void done(const Unit&) const {}
};

struct Order8 {
    int nN, nwg, G, c, q, rev = 0, wgm = WGM;
    __host__ __device__ void init(int M, int N, int G_, int c_) { nN = N / BM; nwg = (M / BM) * nN; G = G_; c = c_; q = nwg / NXCD; }
    __host__ __device__ bool next(int i, Unit& u) const {
        const int L0 = i * G + c; if (L0 >= nwg) return false; const int L = rev ? nwg - 1 - L0 : L0;
        const int wgid = (L % NXCD) * q + L / NXCD, nig = wgm * nN, gid = wgid / nig, w = wgid % nig;
        u.pm = gid * wgm + (w % wgm); u.pn = w / wgm; u.kq = 0; return true;
    }
    __device__ __forceinline__ void a_ready(const Unit&) const {}
    __device__ __forceinline__ void done(const Unit&) const {}
};

struct GateOrder {
    int r, nr, nM;
    __device__ __forceinline__ bool next(int i, Unit& u) const { const int idx = r + i * nr; if (idx >= nM) return false; u.pm = idx; u.pn = 24; u.kq = 0; return true; }
    __device__ __forceinline__ void a_ready(const Unit&) const {}
    __device__ __forceinline__ void done(const Unit&) const {}
};

struct SplitK4Order {
    int c;
    __device__ __forceinline__ bool next(int i, Unit& u) const { if (i > 0 || c >= 256) return false; const int t = c >> 2; u.kq = c & 3; u.pm = t & 7; u.pn = t >> 3; return true; }
    __device__ __forceinline__ void a_ready(const Unit&) const {}
    __device__ __forceinline__ void done(const Unit&) const {}
};

__device__ __forceinline__ unsigned cvt_pk_bf16(float lo, float hi) { unsigned r; asm volatile("v_cvt_pk_bf16_f32 %0, %1, %2" : "=v"(r) : "v"(lo), "v"(hi)); return r; }
typedef float f32x2 __attribute__((ext_vector_type(2)));

constexpr int E_DM = 2048, E_NMOD = 12288, E_ML = 32768;
typedef _Float16 h16_t; typedef _Float16 h16x8 __attribute__((ext_vector_type(8))); typedef float f32x8 __attribute__((ext_vector_type(8)));
__device__ __forceinline__ void epi_glds4(const float* src, PG8_LAS unsigned char* dst) { __builtin_amdgcn_global_load_lds((const unsigned*)src, (PG8_LAS unsigned*)dst, 4, 0, 0); }
__device__ __forceinline__ float epi_sum4(float v) {
    float a = v, b = v; asm volatile("s_nop 1\n\tv_permlane16_swap_b32 %0, %1" : "+v"(a), "+v"(b)); a += b; b = a; asm volatile("s_nop 1\n\tv_permlane32_swap_b32 %0, %1" : "+v"(a), "+v"(b)); return a + b; }
struct EpiRes {
    static constexpr bool PERM = true, AFTER_DRAIN = false, DUPOK = false;
    static constexpr int NST_LO = 8, NST_HI = 8; __device__ __forceinline__ bool nst_hi() const { return false; }
    h16_t* hl; const h16_t* hin; const float* mods; int goff; int dummy;
    bf16_t* un; float* ssacc; const float* gain_n; const float* sc_n;
    __device__ __forceinline__ void prefetch(const Unit& u, PG8_LAS unsigned char* xl, int par, int wid, int lane) const {
        PG8_LAS unsigned char* d = xl + par * 4096; const int bidx = u.pm >> 4, c = u.pn * BM + 64 * (wid & 3) + lane;
        if (wid < 4) { epi_glds4(mods + bidx * E_NMOD + goff + c, d + wid * 256); if (un) epi_glds4(sc_n + bidx * E_NMOD + c, d + 2048 + wid * 256); }
        else if (un) epi_glds4(gain_n + c, d + 1024 + (wid - 4) * 256);
    }
    __device__ __forceinline__ void operator()(const f32x4 (&acc)[2][2][4][2], const Unit& u, int wr, int wc, int fr, int fq, PG8_LAS unsigned char* xl, int par) const {
        { unsigned z_ = 0u; asm volatile("" : "+s"(z_)); const int l_ = (int)__builtin_amdgcn_mbcnt_hi(~0u, __builtin_amdgcn_mbcnt_lo(~0u, z_)); fr = l_ & 15; fq = l_ >> 4; }
        const int bidx = u.pm >> 4;
        h16_t* base = hl + (size_t)(dummy ? (u.pm & 63) : u.pm) * 256 * E_DM;
        const h16_t* rbase = (dummy ? (const h16_t*)hl : hin) + (size_t)(dummy ? (u.pm & 63) : u.pm) * 256 * E_DM;
        float* sbase = ssacc + (size_t)u.pm * 256; const unsigned ulo = (unsigned)lds_byte(fr, 8 * fq) + (unsigned)(wc & 1) * 1024u;
        int col0 = u.pn * BM + wc * 32 + 8 * fq; const int rl = wr * 64 + fr; asm volatile("" : "+v"(col0));
        const unsigned o0 = (unsigned)(rl * E_DM + col0);
        PG8_LAS unsigned char* xd = xl + par * 4096; const int cl = wc * 32 + 8 * fq;
        f32x4 gv[2][2], an[2][2];
#pragma unroll
        for (int bj = 0; bj < 2; ++bj)
#pragma unroll
            for (int n = 0; n < 2; ++n) { gv[bj][n] = *(const PG8_LAS f32x4*)(xd + (cl + bj * HALF + n * 4) * 4);
                if (un) { const f32x4 g = *(const PG8_LAS f32x4*)(xd + 1024 + (cl + bj * HALF + n * 4) * 4), sc = *(const PG8_LAS f32x4*)(xd + 2048 + (cl + bj * HALF + n * 4) * 4); an[bj][n] = g * (sc + 1.f); } }
#pragma unroll
        for (int ai = 0; ai < 2; ++ai) {
            unsigned og = o0 + (unsigned)(ai * HALF * E_DM); asm volatile("" : "+v"(og));
            u32x4 hw[4][2];
#pragma unroll
            for (int m = 0; m < 4; ++m)
#pragma unroll
                for (int bj = 0; bj < 2; ++bj) hw[m][bj] = *(const u32x4*)(rbase + (og + (unsigned)(m * 16 * E_DM + bj * HALF)));
#pragma unroll
            for (int m = 0; m < 4; ++m) { float ss = 0.f;
#pragma unroll
                for (int bj = 0; bj < 2; ++bj) { const unsigned oo = og + (unsigned)(m * 16 * E_DM + bj * HALF);
                    const f32x8 hf = __builtin_convertvector(__builtin_bit_cast(h16x8, hw[m][bj]), f32x8);
                    const f32x4 oa = __builtin_shufflevector(hf, hf, 0, 1, 2, 3) + gv[bj][0] * acc[ai][bj][m][0], ob = __builtin_shufflevector(hf, hf, 4, 5, 6, 7) + gv[bj][1] * acc[ai][bj][m][1];
                    *(h16x8*)(base + oo) = __builtin_convertvector(__builtin_shufflevector(oa, ob, 0, 1, 2, 3, 4, 5, 6, 7), h16x8);
                    if (un) { ss += ((oa[0] * oa[0] + oa[1] * oa[1]) + (oa[2] * oa[2] + oa[3] * oa[3])) + ((ob[0] * ob[0] + ob[1] * ob[1]) + (ob[2] * ob[2] + ob[3] * ob[3]));
                        const f32x4 qa = oa * an[bj][0], qb = ob * an[bj][1];
                        u32x4 w; w.x = cvt_pk_bf16(qa[0], qa[1]); w.y = cvt_pk_bf16(qa[2], qa[3]); w.z = cvt_pk_bf16(qb[0], qb[1]); w.w = cvt_pk_bf16(qb[2], qb[3]); *(u32x4*)((char*)un + (((size_t)(u.pm * 2 + ai) * (E_DM >> 6) + (u.pn * 4 + bj * 2 + (wc >> 1))) * HTB + (unsigned)((wr * 4 + m) * 2) * 1024u + ulo)) = w; } }
                if (un) { ss = epi_sum4(ss); if (fq == 0) __builtin_amdgcn_global_atomic_fadd_f32((__attribute__((address_space(1))) float*)(sbase + (rl + ai * HALF + m * 16)), ss);     } }
                asm volatile("" ::: "memory"); }
    }
};
struct NormIn {
    const float* ssl; const float* ssc; const float* bv; int N;
    __device__ __forceinline__ float rstd(const Unit& u, int rloc) const { const float ss = u.pm >= 128 ? ssc[(u.pm - 128) * 256 + rloc] : ssl[u.pm * 256 + rloc]; return 1.f / sqrtf(ss * (1.f / E_DM) + 1e-6f); }
    __device__ __forceinline__ const float* bias(const Unit& u) const { return bv + (size_t)(u.pm >= 128 ? 8 : (u.pm >> 4)) * N; }
    __device__ __forceinline__ void prefetch(const Unit& u, PG8_LAS unsigned char* xl, int par, int wid, int lane) const {
        PG8_LAS unsigned char* d = xl + par * 4096;
        if (wid < 4) epi_glds4((u.pm >= 128 ? ssc + (u.pm - 128) * 256 : ssl + u.pm * 256) + 64 * wid + lane, d + wid * 256);
        else epi_glds4(bias(u) + u.pn * BM + 64 * (wid - 4) + lane, d + 1024 + (wid - 4) * 256);
    }
    __device__ __forceinline__ float rstd_l(PG8_LAS unsigned char* d, int rloc) const { return __builtin_amdgcn_rsqf(*(const PG8_LAS float*)(d + rloc * 4) * (1.f / E_DM) + 1e-6f); }
};
struct EpiPart {
    static constexpr bool PERM = true, AFTER_DRAIN = false, DUPOK = false;
    static constexpr int NST_LO = 0, NST_HI = 0; __device__ __forceinline__ bool nst_hi() const { return false; }
    h16_t* P;
    __device__ __forceinline__ void prefetch(const Unit&, PG8_LAS unsigned char*, int, int, int) const {}
    __device__ __forceinline__ void operator()(const f32x4 (&acc)[2][2][4][2], const Unit& u, int wr, int wc, int fr, int fq, PG8_LAS unsigned char* xl, int par) const {
        { unsigned z_ = 0u; asm volatile("" : "+s"(z_)); const int l_ = (int)__builtin_amdgcn_mbcnt_hi(~0u, __builtin_amdgcn_mbcnt_lo(~0u, z_)); fr = l_ & 15; fq = l_ >> 4; }
        h16_t* base = P + ((size_t)u.kq * 2048 + (size_t)u.pm * BM) * E_DM; const int col0 = u.pn * BM + wc * 32 + 8 * fq, rl = wr * 64 + fr;
#pragma unroll
        for (int ai = 0; ai < 2; ++ai)
#pragma unroll
            for (int m = 0; m < 4; ++m) { h16_t* rowp = base + (size_t)(rl + ai * HALF + m * 16) * E_DM + col0;
#pragma unroll
                for (int bj = 0; bj < 2; ++bj) *(h16x8*)(rowp + bj * HALF) = __builtin_convertvector(__builtin_shufflevector(acc[ai][bj][m][0], acc[ai][bj][m][1], 0, 1, 2, 3, 4, 5, 6, 7), h16x8); }
    }
};
struct EpiSqRelu {
    static constexpr bool PERM = true, AFTER_DRAIN = false, DUPOK = true;
    static constexpr int NST_LO = 16, NST_HI = 16; __device__ __forceinline__ bool nst_hi() const { return false; }
    bf16_t* O; int ldc; NormIn ni;
    __device__ __forceinline__ void prefetch(const Unit& u, PG8_LAS unsigned char* xl, int par, int wid, int lane) const { ni.prefetch(u, xl, par, wid, lane); }
    __device__ __forceinline__ void operator()(const f32x4 (&acc)[2][2][4][2], const Unit& u, int wr, int wc, int fr, int fq, PG8_LAS unsigned char* xl, int par) const {
        { unsigned z_ = 0u; asm volatile("" : "+s"(z_)); const int l_ = (int)__builtin_amdgcn_mbcnt_hi(~0u, __builtin_amdgcn_mbcnt_lo(~0u, z_)); fr = l_ & 15; fq = l_ >> 4; }
        PG8_LAS unsigned char* xd = xl + par * 4096; const int cl = wc * 32 + 8 * fq;
        char* ob = (char*)O; const unsigned lo = (unsigned)lds_byte(fr, 8 * fq) + (unsigned)(wc & 1) * 1024u;
        f32x4 bv[2][2];
#pragma unroll
        for (int bj = 0; bj < 2; ++bj) { bv[bj][0] = *(const PG8_LAS f32x4*)(xd + 1024 + (cl + bj * HALF) * 4); bv[bj][1] = *(const PG8_LAS f32x4*)(xd + 1024 + (cl + bj * HALF + 4) * 4); }
#pragma unroll
        for (int ai = 0; ai < 2; ++ai)
#pragma unroll
            for (int m = 0; m < 4; ++m) { const float rs = ni.rstd_l(xd, wr * 64 + fr + ai * HALF + m * 16);
#pragma unroll
                for (int bj = 0; bj < 2; ++bj) { f32x4 v0 = acc[ai][bj][m][0] * rs + bv[bj][0], v1 = acc[ai][bj][m][1] * rs + bv[bj][1];
#pragma unroll
                    for (int j = 0; j < 4; ++j) { const float a = fmaxf(v0[j], 0.f), b = fmaxf(v1[j], 0.f); v0[j] = a * a; v1[j] = b * b; }
                    u32x4 w; w.x = cvt_pk_bf16(v0[0], v0[1]); w.y = cvt_pk_bf16(v0[2], v0[3]); w.z = cvt_pk_bf16(v1[0], v1[1]); w.w = cvt_pk_bf16(v1[2], v1[3]);
#ifdef NT_HID
                    __builtin_nontemporal_store(w, (u32x4*)(ob + (((size_t)(u.pm * 2 + ai) * (ldc >> 6) + (u.pn * 4 + bj * 2 + (wc >> 1))) * HTB + (unsigned)((wr * 4 + m) * 2) * 1024u + lo)));
#else
                    *(u32x4*)(ob + (((size_t)(u.pm * 2 + ai) * (ldc >> 6) + (u.pn * 4 + bj * 2 + (wc >> 1))) * HTB + (unsigned)((wr * 4 + m) * 2) * 1024u + lo)) = w;
#endif
#ifdef DUP_ST
                    asm volatile("" ::: "memory"); *(u32x4*)(ob + (((size_t)(u.pm * 2 + ai) * (ldc >> 6) + (u.pn * 4 + bj * 2 + (wc >> 1))) * HTB + (unsigned)((wr * 4 + m) * 2) * 1024u + lo)) = w;
#endif
                    } }
    }
};
struct EpiQKV {
    static constexpr bool PERM = true, AFTER_DRAIN = false, DUPOK = false;
    static constexpr int NST_LO = 0, NST_HI = 0; __device__ __forceinline__ bool nst_hi() const { return false; }
    bf16_t* O; int ldc; int qtiles; float qscale; NormIn ni;
    __device__ __forceinline__ void prefetch(const Unit& u, PG8_LAS unsigned char* xl, int par, int wid, int lane) const { ni.prefetch(u, xl, par, wid, lane); }
    __device__ __forceinline__ void operator()(const f32x4 (&acc)[2][2][4][2], const Unit& u, int wr, int wc, int fr, int fq, PG8_LAS unsigned char* xl, int par) const {
        { unsigned z_ = 0u; asm volatile("" : "+s"(z_)); const int l_ = (int)__builtin_amdgcn_mbcnt_hi(~0u, __builtin_amdgcn_mbcnt_lo(~0u, z_)); fr = l_ & 15; fq = l_ >> 4; }
        int col0 = u.pn * BM + wc * 32 + 8 * fq; asm volatile("" : "+v"(col0)); const float sc = u.pn < qtiles ? qscale : 1.f; PG8_LAS unsigned char* xd = xl + par * 4096; const int cl = wc * 32 + 8 * fq; bf16_t* tb = O + (size_t)u.pm * BM * ldc; const unsigned o0 = (unsigned)((wr * 64 + fr) * ldc + col0);
        f32x4 bv[2][2];
#pragma unroll
        for (int bj = 0; bj < 2; ++bj) { bv[bj][0] = *(const PG8_LAS f32x4*)(xd + 1024 + (cl + bj * HALF) * 4); bv[bj][1] = *(const PG8_LAS f32x4*)(xd + 1024 + (cl + bj * HALF + 4) * 4); }
#pragma unroll
        for (int ai = 0; ai < 2; ++ai)
#pragma unroll
            for (int m = 0; m < 4; ++m) { unsigned og = o0 + (unsigned)((ai * HALF + m * 16) * ldc); asm volatile("" : "+v"(og)); bf16_t* rowp = tb + og; const float rs = ni.rstd_l(xd, wr * 64 + fr + ai * HALF + m * 16);
#pragma unroll
                for (int bj = 0; bj < 2; ++bj) { const f32x4 v0 = (acc[ai][bj][m][0] * rs + bv[bj][0]) * sc, v1 = (acc[ai][bj][m][1] * rs + bv[bj][1]) * sc;
                    u32x4 w; w.x = cvt_pk_bf16(v0[0], v0[1]); w.y = cvt_pk_bf16(v0[2], v0[3]); w.z = cvt_pk_bf16(v1[0], v1[1]); w.w = cvt_pk_bf16(v1[2], v1[3]);
                    *(u32x4*)(rowp + bj * HALF) = w; } }
    }
};
struct EpiMl {
    static constexpr bool PERM = true, AFTER_DRAIN = false, DUPOK = false;
    static constexpr int NST_LO = 0, NST_HI = 0; __device__ __forceinline__ bool nst_hi() const { return false; }
    bf16_t *Q, *K, *V, *OG; float* G; const float* bgate; const PG8_LAS unsigned char* ropel; NormIn ni;
    __device__ __forceinline__ void prefetch(const Unit& u, PG8_LAS unsigned char* xl, int par, int wid, int lane) const { ni.prefetch(u, xl, par, wid, lane); }
    __device__ __forceinline__ void operator()(const f32x4 (&accr)[2][2][4][2], const Unit& u, int wr, int wc, int fr, int fq, PG8_LAS unsigned char* xl, int par) const {
        { unsigned z_ = 0u; asm volatile("" : "+s"(z_)); const int l_ = (int)__builtin_amdgcn_mbcnt_hi(~0u, __builtin_amdgcn_mbcnt_lo(~0u, z_)); fr = l_ & 15; fq = l_ >> 4; }
        const int row0 = u.pm * BM + wr * 64 + fr;
        f32x4 bv[2][2]; float rs8[2][4];
        { PG8_LAS unsigned char* xd = xl + par * 4096; const int cl = wc * 32 + 8 * fq;
#pragma unroll
          for (int bj = 0; bj < 2; ++bj) { bv[bj][0] = *(const PG8_LAS f32x4*)(xd + 1024 + (cl + bj * HALF) * 4); bv[bj][1] = *(const PG8_LAS f32x4*)(xd + 1024 + (cl + bj * HALF + 4) * 4); }
#pragma unroll
          for (int ai = 0; ai < 2; ++ai)
#pragma unroll
              for (int m = 0; m < 4; ++m) rs8[ai][m] = ni.rstd_l(xd, wr * 64 + fr + ai * HALF + m * 16); }
#define acc_at(ai, bj, m, n) (accr[ai][bj][m][n] * rs8[ai][m] + bv[bj][n])
        if (u.pn < 8) {
            bf16_t* dst = u.pn < 4 ? Q : K; const float ksc = u.pn < 4 ? 1.f : 0.08838834764831845f; const bool lat = u.pm < 128;
            const int col0 = (u.pn & 3) * BM + wc * 32 + 8 * fq, half = wc >> 1, j0 = 16 * (wc & 1) + 4 * fq;
#pragma unroll
            for (int ai = 0; ai < 2; ++ai)
#pragma unroll
                for (int m = 0; m < 4; ++m) {
                    const int pos = half ? (16 * m + fr) : ((4 * u.pm + 2 * ai + wr) & 63);
                    const PG8_LAS f32x4* rp = (const PG8_LAS f32x4*)(ropel + pos * 272 + j0 * 8); const f32x4 cs0 = rp[0], cs1 = rp[1];
                    unsigned og = (unsigned)((wr * 64 + fr + ai * HALF + m * 16) * 1024 + col0); asm volatile("" : "+v"(og)); bf16_t* rowp = dst + (size_t)u.pm * BM * 1024 + og;
#pragma unroll
                    for (int bj = 0; bj < 2; ++bj) { f32x4 v0 = acc_at(ai, bj, m, 0), v1 = acc_at(ai, bj, m, 1);
                        if (lat) { f32x4 r0, r1;
                            r0[0] = v0[0] * cs0[0] - v0[1] * cs0[1]; r0[1] = v0[0] * cs0[1] + v0[1] * cs0[0];
                            r0[2] = v0[2] * cs0[2] - v0[3] * cs0[3]; r0[3] = v0[2] * cs0[3] + v0[3] * cs0[2];
                            r1[0] = v1[0] * cs1[0] - v1[1] * cs1[1]; r1[1] = v1[0] * cs1[1] + v1[1] * cs1[0];
                            r1[2] = v1[2] * cs1[2] - v1[3] * cs1[3]; r1[3] = v1[2] * cs1[3] + v1[3] * cs1[2];
                            v0 = r0; v1 = r1; }
                        v0 = v0 * ksc; v1 = v1 * ksc;
                        u32x4 w; w.x = cvt_pk_bf16(v0[0], v0[1]); w.y = cvt_pk_bf16(v0[2], v0[3]); w.z = cvt_pk_bf16(v1[0], v1[1]); w.w = cvt_pk_bf16(v1[2], v1[3]);
                        *(u32x4*)(rowp + bj * HALF) = w; } }
        } else if (u.pn < 24) {
            const bool isog = u.pn >= 16; bf16_t* dst = isog ? OG : V; const int col0 = ((u.pn - 8) & 7) * BM + wc * 32 + 8 * fq;
#pragma unroll
            for (int ai = 0; ai < 2; ++ai)
#pragma unroll
                for (int m = 0; m < 4; ++m) { unsigned og = (unsigned)((wr * 64 + fr + ai * HALF + m * 16) * 2048 + col0); asm volatile("" : "+v"(og)); bf16_t* rowp = dst + (size_t)u.pm * BM * 2048 + og;
#pragma unroll
                    for (int bj = 0; bj < 2; ++bj) { f32x4 v0 = acc_at(ai, bj, m, 0), v1 = acc_at(ai, bj, m, 1);
                        if (isog) {
#pragma unroll
                            for (int j = 0; j < 4; ++j) { v0[j] = __builtin_amdgcn_rcpf(1.f + __expf(-v0[j])); v1[j] = __builtin_amdgcn_rcpf(1.f + __expf(-v1[j])); } }
                        u32x4 w; w.x = cvt_pk_bf16(v0[0], v0[1]); w.y = cvt_pk_bf16(v0[2], v0[3]); w.z = cvt_pk_bf16(v1[0], v1[1]); w.w = cvt_pk_bf16(v1[2], v1[3]);
                        *(u32x4*)(rowp + bj * HALF) = w; } }
        } else if (wc == 0) {
            const f32x4 b0 = *(const f32x4*)(bgate + 8 * fq), b1 = *(const f32x4*)(bgate + 8 * fq + 4); const bool isf = (fq & 1) != 0;
#pragma unroll
            for (int ai = 0; ai < 2; ++ai)
#pragma unroll
                for (int m = 0; m < 4; ++m) { f32x4 v0 = acc_at(ai, 0, m, 0) + b0, v1 = acc_at(ai, 0, m, 1) + b1;
#pragma unroll
                    for (int j = 0; j < 4; ++j) {
                        float a = v0[j] * (1.f / 15.f), b = v1[j] * (1.f / 15.f);
                        a = 15.f * (1.f - 2.f * __builtin_amdgcn_rcpf(__expf(2.f * a) + 1.f)); b = 15.f * (1.f - 2.f * __builtin_amdgcn_rcpf(__expf(2.f * b) + 1.f));
                        if (isf) { a = fminf(a, 0.f) - log1pf(__expf(-fabsf(a))); b = fminf(b, 0.f) - log1pf(__expf(-fabsf(b))); }
                        v0[j] = a; v1[j] = b; }
                    float* gp = G + (size_t)(row0 + ai * HALF + m * 16) * 32 + 8 * fq; *(f32x4*)gp = v0; *(f32x4*)(gp + 4) = v1; }
        }
    }
#undef acc_at
};
template <int N> __device__ __forceinline__ void pg8_wait_vm() { asm volatile("s_waitcnt vmcnt(%0)" :: "n"(N) : "memory"); }
template <class Epi, class Sched, bool ALIGN_EPI = false, bool SP2 = false, bool NARROW = false>
__device__ __forceinline__ void gemm_phase(PG8_LAS unsigned char* lds, const Gemm g, const Sched& S, const Epi& E, const int tid_in) {
    const int tid = tid_in, wid = __builtin_amdgcn_readfirstlane(tid >> 6), lane = tid & 63, wr = wid >> 2, wc = wid & 3, fr = lane & 15, fq = lane >> 4;
    const int K = g.ld, nt = g.K / BK;
    unsigned voffA[2], voffB[2];
#pragma unroll
    for (int i = 0; i < 2; ++i) { int R, C; stage_rc(tid * 16 + i * 8192, R, C); const int Rb = Epi::PERM ? ((R & ~31) + perm32(R & 31)) : R;
        voffA[i] = g.ablk ? (unsigned)(tid * 16 + i * 8192) : (unsigned)(R * K + C) * 2u; voffB[i] = g.bblk ? (unsigned)(tid * 16 + i * 8192) : (unsigned)(Rb * K + C) * 2u; }
    const size_t kstep = (size_t)(BK * 2);
    const size_t kstepA = g.ablk ? (size_t)HTB : kstep;
    const size_t kqA = g.ablk ? (size_t)g.K * 256 : (size_t)g.K * 2;
    const size_t kstepB = g.bblk ? (size_t)HTB : kstep, kqB = g.bblk ? (size_t)g.K * 256 : (size_t)g.K * 2;
    const size_t hstep = (size_t)HALF * K * 2;
    const size_t tstep = 2 * hstep;
    const unsigned ldsw = (unsigned)wid * 1024u;
    const int aoff = lds_byte(wr * 64 + fr, fq * 8), boff = lds_byte(wc * 32 + fr, fq * 8);
#define PG8_SA(b, h) (((b) * 2 + (h)) * HTB)
#define PG8_SB(b, h) ((4 + (b) * 2 + (h)) * HTB)
#define PG8_STAGE(bufoff, gbase, voff) do { _Pragma("unroll") for (int _i = 0; _i < 2; ++_i) \
        __builtin_amdgcn_global_load_lds((const unsigned*)((const char*)(gbase) + (voff)[_i]), (PG8_LAS unsigned*)(lds + (bufoff) + ldsw + _i * 8192), 16, 0, 0); } while (0)
#define PG8_LDA(dst, b, h) do { if (!NARROW || wc == 0) _Pragma("unroll") for (int m = 0; m < 4; ++m) _Pragma("unroll") for (int k = 0; k < 2; ++k) dst[m][k] = *(const PG8_LAS bf16x8*)(lds + PG8_SA(b, h) + aoff + m * 2048 + k * 1024); } while (0)
#define PG8_LDB(dst, b, h) do { if (!NARROW || ((h) == 0 && wc == 0)) _Pragma("unroll") for (int n = 0; n < 2; ++n) _Pragma("unroll") for (int k = 0; k < 2; ++k) dst[n][k] = *(const PG8_LAS bf16x8*)(lds + PG8_SB(b, h) + boff + n * 2048 + k * 1024); } while (0)
#define PG8_MMA(ai, bj, At, Bt) do { if (NARROW && ((bj) != 0 || wc != 0)) break; __builtin_amdgcn_s_setprio(1); _Pragma("unroll") for (int m = 0; m < 4; ++m) _Pragma("unroll") for (int n = 0; n < 2; ++n) _Pragma("unroll") for (int k = 0; k < 2; ++k) \
        acc[ai][bj][m][n] = __builtin_amdgcn_mfma_f32_16x16x32_bf16(Bt[n][k], At[m][k], acc[ai][bj][m][n], 0, 0, 0); __builtin_amdgcn_s_setprio(0); } while (0)
#define PG8_WAIT_V(n) asm volatile("s_waitcnt vmcnt(" #n ")" ::: "memory")
#define PG8_WAIT_L(n) asm volatile("s_waitcnt lgkmcnt(" #n ")" ::: "memory")
#define PG8_BAR __builtin_amdgcn_s_barrier()
#define PG8_SCHED __builtin_amdgcn_sched_barrier(0)
    Unit cur, nxt; int ui = 0;
    if (!S.next(0, cur)) return;
    f32x4 acc[2][2][4][2];
#pragma unroll
    for (int a = 0; a < 2; ++a)
#pragma unroll
        for (int b = 0; b < 2; ++b)
#pragma unroll
            for (int m = 0; m < 4; ++m)
#pragma unroll
                for (int n = 0; n < 2; ++n) acc[a][b][m][n] = (f32x4){0.f, 0.f, 0.f, 0.f};
    bf16x8 At[4][2], B0[2][2], B1[2][2];
    const char* cA = (const char*)g.A + (size_t)cur.pm * tstep + (size_t)cur.kq * kqA; const char* cB = (const char*)g.Bt + (size_t)cur.pn * tstep + (size_t)cur.kq * kqB;
    PG8_LAS unsigned char* const xl = lds + STAGE_BYTES + 1024;
    S.a_ready(cur); E.prefetch(cur, xl, 0, wid, lane);
    if constexpr (SP2) {
        PG8_STAGE(PG8_SB(0, 0), cB, voffB); PG8_STAGE(PG8_SB(0, 1), cB + hstep, voffB); PG8_STAGE(PG8_SA(0, 0), cA, voffA); PG8_STAGE(PG8_SA(0, 1), cA + hstep, voffA);
        if (wr == 1) PG8_BAR;
        PG8_WAIT_V(2); PG8_BAR;
        PG8_STAGE(PG8_SB(1, 0), cB + kstepB, voffB); PG8_STAGE(PG8_SA(1, 0), cA + kstepA, voffA); PG8_STAGE(PG8_SB(1, 1), cB + hstep + kstepB, voffB);
        PG8_WAIT_V(6); PG8_BAR;
    } else {
        PG8_STAGE(PG8_SB(0, 0), cB, voffB); PG8_STAGE(PG8_SA(0, 0), cA, voffA); PG8_STAGE(PG8_SB(0, 1), cB + hstep, voffB); PG8_STAGE(PG8_SA(0, 1), cA + hstep, voffA);
        if (wr == 1) PG8_BAR;
        PG8_WAIT_V(4); PG8_BAR;
        PG8_STAGE(PG8_SB(1, 0), cB + kstepB, voffB); PG8_STAGE(PG8_SA(1, 0), cA + kstepA, voffA); PG8_STAGE(PG8_SB(1, 1), cB + hstep + kstepB, voffB);
        PG8_WAIT_V(6); PG8_BAR;
    }
    for (;;) {
        const bool has_next = S.next(ui + 1, nxt);
        const char* nA = has_next ? (const char*)g.A + (size_t)nxt.pm * tstep + (size_t)nxt.kq * kqA : cA; const char* nB = has_next ? (const char*)g.Bt + (size_t)nxt.pn * tstep + (size_t)nxt.kq * kqB : cB;
        for (int t = 0; t < nt; t += 2) {
            const bool last = (t == nt - 2);
            const char* a1 = cA + (size_t)(t + 1) * kstepA;
            const char* a2 = last ? nA : cA + (size_t)(t + 2) * kstepA; const char* b2 = last ? nB : cB + (size_t)(t + 2) * kstepB;
            const char* a3 = a2 + kstepA; const char* b3 = b2 + kstepB;
            if (last && has_next) { S.a_ready(nxt); E.prefetch(nxt, xl, (ui + 1) & 1, wid, lane); }
            if constexpr (SP2) {
#define PG8_SP12(WAITV) do { \
            PG8_LDB(B0, 0, 0); PG8_LDB(B1, 0, 1); PG8_SCHED; PG8_LDA(At, 0, 0); PG8_STAGE(PG8_SA(1, 1), a1 + hstep, voffA); \
            WAITV; PG8_WAIT_L(0); PG8_BAR; PG8_MMA(0, 0, At, B0); PG8_MMA(0, 1, At, B1); PG8_BAR; PG8_SCHED; \
            PG8_LDA(At, 0, 1); PG8_STAGE(PG8_SB(0, 0), b2, voffB); PG8_STAGE(PG8_SB(0, 1), b2 + hstep, voffB); PG8_STAGE(PG8_SA(0, 0), a2, voffA); \
            WAITV; PG8_WAIT_L(0); PG8_BAR; PG8_MMA(1, 0, At, B0); PG8_MMA(1, 1, At, B1); PG8_BAR; PG8_SCHED; } while (0)
            if constexpr (Epi::NST_LO > 0) PG8_SP12(do { if (t == 0 && ui > 0) pg8_wait_vm<8 + Epi::NST_LO>(); else PG8_WAIT_V(8); } while (0)); else PG8_SP12(PG8_WAIT_V(8));
            PG8_LDB(B0, 1, 0); PG8_LDB(B1, 1, 1); PG8_SCHED; PG8_LDA(At, 1, 0); PG8_STAGE(PG8_SA(0, 1), a2 + hstep, voffA);
            PG8_WAIT_V(8); PG8_WAIT_L(0); PG8_BAR; PG8_MMA(0, 0, At, B0); PG8_MMA(0, 1, At, B1); PG8_BAR; PG8_SCHED;
            PG8_LDA(At, 1, 1); PG8_STAGE(PG8_SB(1, 0), b3, voffB); PG8_STAGE(PG8_SB(1, 1), b3 + hstep, voffB); PG8_STAGE(PG8_SA(1, 0), a3, voffA);
            PG8_WAIT_V(8); PG8_WAIT_L(0); PG8_BAR; PG8_MMA(1, 0, At, B0); PG8_MMA(1, 1, At, B1); PG8_BAR; PG8_SCHED;
            } else {
            PG8_LDB(B0, 0, 0); PG8_SCHED; PG8_LDA(At, 0, 0); PG8_STAGE(PG8_SA(1, 1), a1 + hstep, voffA);
            PG8_WAIT_L(8); PG8_BAR; PG8_WAIT_L(0); PG8_MMA(0, 0, At, B0); PG8_BAR; PG8_SCHED;
            PG8_LDB(B1, 0, 1); PG8_STAGE(PG8_SB(0, 0), b2, voffB);
            PG8_BAR; PG8_WAIT_L(0); PG8_MMA(0, 1, At, B1); PG8_BAR;
            PG8_LDA(At, 0, 1); PG8_STAGE(PG8_SA(0, 0), a2, voffA);
            PG8_BAR; PG8_WAIT_L(0); PG8_MMA(1, 0, At, B0); PG8_BAR; PG8_SCHED;
            PG8_STAGE(PG8_SB(0, 1), b2 + hstep, voffB);
            PG8_WAIT_V(6); PG8_BAR; PG8_MMA(1, 1, At, B1); PG8_BAR;
            PG8_LDB(B0, 1, 0); PG8_SCHED; PG8_LDA(At, 1, 0); PG8_STAGE(PG8_SA(0, 1), a2 + hstep, voffA);
            PG8_WAIT_L(8); PG8_BAR; PG8_WAIT_L(0); PG8_MMA(0, 0, At, B0); PG8_BAR; PG8_SCHED;
            PG8_LDB(B1, 1, 1); PG8_STAGE(PG8_SB(1, 0), b3, voffB);
            PG8_BAR; PG8_WAIT_L(0); PG8_MMA(0, 1, At, B1); PG8_BAR;
            PG8_LDA(At, 1, 1); PG8_STAGE(PG8_SA(1, 0), a3, voffA);
            PG8_BAR; PG8_WAIT_L(0); PG8_MMA(1, 0, At, B0); PG8_BAR; PG8_SCHED;
            PG8_STAGE(PG8_SB(1, 1), b3 + hstep, voffB);
            PG8_WAIT_V(6); PG8_BAR; PG8_MMA(1, 1, At, B1); PG8_BAR;
            }
        }
        if constexpr (ALIGN_EPI) { if (wr == 0) PG8_BAR; }
        if constexpr (!Epi::AFTER_DRAIN) { E(acc, cur, wr, wc, fr, fq, xl, ui & 1);
#ifdef DUP_EPI
            if constexpr (Epi::DUPOK) { asm volatile("" ::: "memory"); E(acc, cur, wr, wc, fr, fq, xl, ui & 1); }
#endif
#ifdef DRAIN_EPI
            asm volatile("s_waitcnt vmcnt(0)" ::: "memory");
#endif
            S.done(cur); }
        if (!has_next) break;
#pragma unroll
        for (int a = 0; a < 2; ++a)
#pragma unroll
            for (int b = 0; b < 2; ++b)
#pragma unroll
                for (int m = 0; m < 4; ++m)
#pragma unroll
                    for (int n = 0; n < 2; ++n) acc[a][b][m][n] = (f32x4){0.f, 0.f, 0.f, 0.f};
        cur = nxt; cA = nA; cB = nB; ++ui;
        if constexpr (ALIGN_EPI) { if (wr == 1) PG8_BAR; }
    }
    PG8_WAIT_V(0);
    if constexpr (!ALIGN_EPI) { if (wr == 0) PG8_BAR; }
    PG8_BAR;
    if constexpr (Epi::AFTER_DRAIN) { E.fused(acc, cur, wr, wc, fr, fq, lds, wid, lane); S.done(cur); }
#undef PG8_SA
#undef PG8_SB
#undef PG8_STAGE
#undef PG8_LDA
#undef PG8_LDB
#undef PG8_MMA
#undef PG8_WAIT_V
#undef PG8_WAIT_L
#undef PG8_BAR
#undef PG8_SCHED
}
}

constexpr int DM = 2048, NB = 8, SEQ = 4096, CTXL = 256, DEPTH = 4, DFF = 8192, NMOD = 6 * DM;
constexpr int ML = NB * SEQ, MC = NB * CTXL, MT = ML + MC;
constexpr int ML_NSRC = 6176, ML_NPAD = 6400;
constexpr int NWAVES = 8;
constexpr float RMS_EPS = 1e-6f, LOG2E = 1.4426950408889634f;
constexpr size_t MiB = 1u << 20;
constexpr size_t WS_CTL = 0, CTL_ZERO_BYTES = 1 * MiB;
constexpr size_t WS_MODS = 1 * MiB;
constexpr size_t WS_ROPE = 3 * MiB;
constexpr size_t WS_PART = 4 * MiB;
constexpr size_t WS_HC = 60 * MiB;
constexpr size_t WS_WML_IN = 76 * MiB, WS_WML_OUT = 126 * MiB, WS_WNA_QKV = 142 * MiB, WS_WNA_OUT = 190 * MiB, WS_W1 = 206 * MiB, WS_W2 = 334 * MiB;
constexpr size_t WS_U = 462 * MiB;
constexpr size_t WS_P = 598 * MiB;
constexpr size_t WS_MQ = WS_P, WS_MK = WS_P + 68 * MiB, WS_MV = WS_P + 136 * MiB, WS_MOG = WS_P + 272 * MiB, WS_MG = WS_P + 408 * MiB, WS_HF = WS_P + 413 * MiB, WS_HB = WS_P + 549 * MiB;
constexpr size_t WS_QKV = WS_P;
constexpr size_t WS_HID = WS_P;
constexpr size_t WS_END = WS_P + 685 * MiB;
constexpr size_t WS_PC = WS_END + 30 * MiB;
constexpr size_t WS_U2 = WS_PC + 64 * MiB;
constexpr size_t WS_H16 = WS_U2;
constexpr size_t WS_TOTAL = WS_U2 + 136 * MiB;
constexpr size_t WS_BVIN = WS_PART, WS_BVM1 = WS_PART + 1 * MiB;
constexpr size_t CTL_SSL_A = 512 * 1024, CTL_SSL_B = 640 * 1024, CTL_SSC_A = 768 * 1024, CTL_SSC_B = 776 * 1024;
static_assert(WS_HID + (size_t)MT * DFF * 2 <= WS_END && WS_QKV + (size_t)MT * 6144 * 2 <= WS_END && WS_MG + (size_t)MT * 32 * 4 <= WS_HF && WS_HB + (size_t)MT * DM * 2 <= WS_END, "d_ws map");
constexpr int CW_TMO = 0, CW_BAR = 4096;
constexpr int RING_BYTES = 131072, LDSCTL_OFF = RING_BYTES, MISC_OFF = LDSCTL_OFF + 320, LDS_BYTES = 163840;
constexpr int ROPE_LDS_OFF = LDSCTL_OFF + 1024 + 8192, ROPE_LDS_PITCH = 272;

#define GAS __attribute__((address_space(1)))
#define LAS __attribute__((address_space(3)))
typedef unsigned short bf16;
typedef unsigned v4u __attribute__((ext_vector_type(4)));
typedef float f32x4 __attribute__((ext_vector_type(4)));
typedef short bf16x8 __attribute__((ext_vector_type(8)));
typedef _Float16 h16;
typedef _Float16 h16x4 __attribute__((ext_vector_type(4)));
typedef GAS unsigned gu32;
typedef GAS unsigned long long gu64;
#define RLX_AGENT __ATOMIC_RELAXED, __HIP_MEMORY_SCOPE_AGENT
#define LDS_WAIT() asm volatile("s_waitcnt lgkmcnt(0)" ::: "memory")
#define VM_WAIT() asm volatile("s_waitcnt vmcnt(0)" ::: "memory")
__device__ __forceinline__ unsigned long long rt() { return __builtin_amdgcn_s_memrealtime(); }
__device__ __forceinline__ unsigned f2bf(float f) { unsigned u = __builtin_bit_cast(unsigned, f); return (u + 0x7fffu + ((u >> 16) & 1u)) >> 16; }
__device__ __forceinline__ unsigned pk2(float lo, float hi) { return f2bf(lo) | (f2bf(hi) << 16); }

#define XB_TMO      128
#define XB_XCNT(j)  (256  + 64 * (j))
#define XB_XSUB(j)  (1280 + 64 * (j))
#define XB_XGEN(j)  (2304 + 64 * (j))
#define XB_TOP      3328
#define XB_TOPGEN   3392
#define XB_ARR      3408
#define XCD_BAR_WORDS 3456
#define XB_SPIN_CAP (1u << 18)

__device__ __forceinline__ unsigned xb_ld(unsigned* p)              { return __hip_atomic_load(p, __ATOMIC_RELAXED, __HIP_MEMORY_SCOPE_AGENT); }
__device__ __forceinline__ unsigned xb_add(unsigned* p, unsigned v) { return __hip_atomic_fetch_add(p, v, __ATOMIC_RELAXED, __HIP_MEMORY_SCOPE_AGENT); }
__device__ __forceinline__ unsigned xb_xcc_id() { return (unsigned)__builtin_amdgcn_s_getreg((3 << 11) | 20) & 0xFu; }
#define XB_SPIN(cond, bar) do { unsigned _sp = 0; while (cond) { __builtin_amdgcn_s_sleep(1); \
    if ((++_sp & 255u) == 0u) { if (xb_ld(&(bar)[XB_TMO])) break; if (_sp > XB_SPIN_CAP) { atomicAdd(&(bar)[XB_TMO], 1u); break; } } } } while (0)

typedef unsigned xb_u4 __attribute__((ext_vector_type(4)));
__device__ __forceinline__ unsigned xb_min8(const unsigned* p) {
    xb_u4 lo, hi; asm volatile("global_load_dwordx4 %0, %2, off sc1\n\tglobal_load_dwordx4 %1, %2, off offset:16 sc1\n\ts_waitcnt vmcnt(0)" : "=&v"(lo), "=&v"(hi) : "v"(p) : "memory");
    return min(min(min(lo.x, lo.y), min(lo.z, lo.w)), min(min(hi.x, hi.y), min(hi.z, hi.w)));
}
#define XB_POLL8(bar, k) do { unsigned _sp = 0; for (;;) { \
        if (xb_min8(&(bar)[XB_ARR]) > (k)) break; __builtin_amdgcn_s_sleep(1); \
        if ((++_sp & 255u) == 0u) { if (xb_ld(&(bar)[XB_TMO])) break; if (_sp > XB_SPIN_CAP) { atomicAdd(&(bar)[XB_TMO], 1u); break; } } } } while (0)
struct XcdBarrier {
    unsigned* bar; unsigned x;
    volatile LAS unsigned* st;
};

__device__ __forceinline__ XcdBarrier xcd_barrier_post(unsigned* bar, volatile LAS unsigned* st) {
    XcdBarrier b; b.bar = bar; b.x = xb_xcc_id(); b.st = st;
    if (threadIdx.x == 0) (void)xb_add(&bar[XB_XCNT(b.x)], 1u);
    return b;
}
__device__ __forceinline__ void xcd_barrier_complete(unsigned* bar, unsigned x, unsigned& nloc, unsigned& nx, unsigned& xmask) {
    const unsigned G = gridDim.x * gridDim.y * gridDim.z;
    unsigned sum, cnt, mine, msk, sp = 0u;
    for (;;) {
        sum = 0u; cnt = 0u; mine = 0u; msk = 0u;
#pragma unroll
        for (unsigned j = 0; j < 16; ++j) { const unsigned c = xb_ld(&bar[XB_XCNT(j)]); sum += c; cnt += (c > 0u) ? 1u : 0u; msk |= (c > 0u) ? (1u << j) : 0u; mine = (j == x) ? c : mine; }
        if (sum == G) break;
        __builtin_amdgcn_s_sleep(1);
        if ((++sp & 255u) == 0u) { if (xb_ld(&bar[XB_TMO])) break; if (sp > XB_SPIN_CAP) { atomicAdd(&bar[XB_TMO], 1u); break; } }
    }
    nloc = mine > 0u ? mine : 1u; nx = cnt > 0u ? cnt : 1u; xmask = msk;
}

__device__ __forceinline__ void xcd_barrier(const XcdBarrier& b) {
    asm volatile("s_waitcnt vmcnt(0)" ::: "memory");
    __syncthreads();
    if (threadIdx.x == 0) {
        unsigned* bar = b.bar;
        __builtin_amdgcn_s_waitcnt(0);
        unsigned nloc = b.st[0], nx = b.st[1];
        unsigned xmask = b.st[3];
        if (nloc == 0u) { xcd_barrier_complete(bar, b.x, nloc, nx, xmask); b.st[0] = nloc; b.st[1] = nx; b.st[3] = xmask; }
        const unsigned kbar = b.st[2]; b.st[2] = kbar + 1u;
        const unsigned old = xb_add(&bar[XB_XSUB(b.x)], 1u);
        const unsigned gen = old / nloc;
        if (old + 1u == (gen + 1u) * nloc) {
            __builtin_amdgcn_fence(__ATOMIC_RELEASE, "agent");
            asm volatile("s_waitcnt vmcnt(0)" ::: "memory");
            if (xmask == 0xFFu) { __hip_atomic_store(&bar[XB_ARR + b.x], kbar + 1u, __ATOMIC_RELAXED, __HIP_MEMORY_SCOPE_AGENT);
                XB_POLL8(bar, kbar); }
            else {
            const unsigned og = xb_add(&bar[XB_TOP], 1u);
            const unsigned tg = og / nx;
            if (og + 1u == (tg + 1u) * nx) xb_add(&bar[XB_TOPGEN], 1u);
            else XB_SPIN(xb_ld(&bar[XB_TOPGEN]) == tg, bar); }
            __builtin_amdgcn_fence(__ATOMIC_ACQUIRE, "agent");
            asm volatile("s_waitcnt vmcnt(0)" ::: "memory");
        } else {
            if (xmask == 0xFFu) XB_POLL8(bar, kbar); else
            XB_SPIN(xb_ld(&bar[XB_TOPGEN]) == kbar, bar);
            __builtin_amdgcn_fence(__ATOMIC_ACQUIRE, "agent");
            asm volatile("s_waitcnt vmcnt(0)" ::: "memory");
        }
    }
    __syncthreads();
}

#define DI __device__ __forceinline__
typedef unsigned u32x4v __attribute__((ext_vector_type(4)));
typedef unsigned u32x2v __attribute__((ext_vector_type(2)));
typedef short s16x4 __attribute__((ext_vector_type(4)));
typedef short v4i16_t __attribute__((ext_vector_type(4)));
struct Args { const float* in[18]; float* out; unsigned char* ws; int ph_lo, ph_hi, li, pad; };
enum { I_X = 0, I_C, I_CTX, I_CCTX, I_ADAW, I_ADAB, I_NMIX, I_NMLP, I_MLWIN, I_MLBG, I_MLNORM, I_MLWOUT, I_NAWQKV, I_NARPB, I_NAWOUT, I_W1, I_W2, I_FNORM };
struct Frame {
    LAS unsigned char* lds; int tid, lane, wave, G;
    float* out; unsigned char* ws;
};
DI float bperm(float v, int src_lane) { return __builtin_bit_cast(float, __builtin_amdgcn_ds_bpermute(src_lane << 2, __builtin_bit_cast(int, v))); }
DI float wave_sum(float v, int lane) {
#pragma unroll
    for (int o = 1; o < 64; o <<= 1) v += bperm(v, lane ^ o);
    return v;
}
typedef __bf16 bf16x2_t __attribute__((ext_vector_type(2)));
typedef float f32x2_t __attribute__((ext_vector_type(2)));
DI unsigned pkbf(float lo, float hi) { const f32x2_t v = {lo, hi}; const bf16x2_t b = __builtin_convertvector(v, bf16x2_t); return __builtin_bit_cast(unsigned, b); }
DI float bf_lo(unsigned w) { return __builtin_bit_cast(float, w << 16); }
DI float bf_hi(unsigned w) { return __builtin_bit_cast(float, w & 0xffff0000u); }
DI float ex2(float x) { return __builtin_amdgcn_exp2f(x); }
DI f32x4 mfma16(bf16x8 a, bf16x8 b, f32x4 c) { return __builtin_amdgcn_mfma_f32_16x16x32_bf16(a, b, c, 0, 0, 0); }
DI s16x4 tr_read(LAS unsigned char* p) { return __builtin_bit_cast(s16x4, __builtin_amdgcn_ds_read_tr16_b64_v4i16((LAS v4i16_t*)p)); }
DI bf16x8 cat8(s16x4 lo, s16x4 hi) { return __builtin_shufflevector(lo, hi, 0, 1, 2, 3, 4, 5, 6, 7); }

template <int MODE> DI void p0_transpose_item(const float* W, int K, int Nsrc, bf16* WT, int nblk, LAS float* scr, int item, int lane) {
    const int kb = item / nblk, nb = item % nblk, k0 = 64 * kb, n0 = 32 * nb;
    int nsrc = n0 + (lane & 31); bool valid = true;
    if (MODE == 1) { if (n0 < 2048) { const int p = nsrc & 127, pp = p & 63; nsrc = (nsrc & ~127) + (p & 64) + (pp >> 1) + 32 * (pp & 1); } valid = n0 < Nsrc; }
#pragma unroll 8
    for (int i = 0; i < 32; ++i) { const int kk = 2 * i + (lane >> 5); scr[kk * 33 + (lane & 31)] = valid ? W[(size_t)(k0 + kk) * Nsrc + nsrc] : 0.f; }
    LDS_WAIT(); asm volatile("" ::: "memory");
    const int c = lane & 7;
#pragma unroll
    for (int j = 0; j < 4; ++j) { const int n = (lane >> 3) + 8 * j; const LAS float* s = scr + (8 * c) * 33 + n;
        v4u o; o.x = pkbf(s[0 * 33], s[1 * 33]); o.y = pkbf(s[2 * 33], s[3 * 33]); o.z = pkbf(s[4 * 33], s[5 * 33]); o.w = pkbf(s[6 * 33], s[7 * 33]);
        *(GAS v4u*)((GAS unsigned char*)WT + pg8::bblk_byte(n0 + n, k0 + 8 * c, K)) = o; }
    LDS_WAIT(); asm volatile("" ::: "memory");
}
DI void sincos_d(double ang, float& co, float& si) {
    const double TWO_PI = 6.283185307179586476925286766559;
    const double r = ang - TWO_PI * __builtin_rint(ang / TWO_PI), r2 = r * r;
    double s = 1.0, c = 1.0;
#pragma unroll
    for (int k = 14; k >= 1; --k) { s = 1.0 - s * r2 / (double)((2 * k) * (2 * k + 1)); c = 1.0 - c * r2 / (double)((2 * k - 1) * (2 * k)); }
    co = (float)c; si = (float)(s * r);
}
DI void p0_prologue(Frame& F, const Args& A) {
    const int gw = blockIdx.x * NWAVES + F.wave, NGW = F.G * NWAVES;
    { const int id = blockIdx.x * 512 + F.tid; if (id < 2048) { const int pos = id >> 5, j = id & 31; double iv = 1.0; for (int t = 0; t < j; ++t) iv *= 0.74989420933245582730; const float ang = (float)pos * (float)iv; float co, si; sincos_d((double)ang, co, si);
        float* R = (float*)(F.ws + WS_ROPE); R[2 * id] = co; R[2 * id + 1] = si; } }
    LAS float* scr = (LAS float*)(F.lds + F.wave * 8704);
    constexpr int T_MLIN = 32 * 200, T_SQ = 32 * 64, T_QKV = 32 * 192, T_W1 = 32 * 256, T_W2 = 128 * 64;
    constexpr int NITEMS = 2 * T_MLIN + 2 * T_SQ + 2 * T_QKV + 2 * T_SQ + 4 * T_W1 + 4 * T_W2;
    for (int it = gw; it < NITEMS; it += NGW) {
        int r = it;
        if (r < 2 * T_MLIN) { const int j = r / T_MLIN; p0_transpose_item<1>(A.in[I_MLWIN] + (size_t)j * DM * ML_NSRC, DM, ML_NSRC, (bf16*)(F.ws + WS_WML_IN) + (size_t)j * ML_NPAD * DM, 200, scr, r % T_MLIN, F.lane); continue; } r -= 2 * T_MLIN;
        if (r < 2 * T_SQ) { const int j = r / T_SQ; p0_transpose_item<0>(A.in[I_MLWOUT] + (size_t)j * DM * DM, DM, DM, (bf16*)(F.ws + WS_WML_OUT) + (size_t)j * DM * DM, 64, scr, r % T_SQ, F.lane); continue; } r -= 2 * T_SQ;
        if (r < 2 * T_QKV) { const int j = r / T_QKV; p0_transpose_item<0>(A.in[I_NAWQKV] + (size_t)j * DM * 6144, DM, 6144, (bf16*)(F.ws + WS_WNA_QKV) + (size_t)j * 6144 * DM, 192, scr, r % T_QKV, F.lane); continue; } r -= 2 * T_QKV;
        if (r < 2 * T_SQ) { const int j = r / T_SQ; p0_transpose_item<0>(A.in[I_NAWOUT] + (size_t)j * DM * DM, DM, DM, (bf16*)(F.ws + WS_WNA_OUT) + (size_t)j * DM * DM, 64, scr, r % T_SQ, F.lane); continue; } r -= 2 * T_SQ;
        if (r < 4 * T_W1) { const int j = r / T_W1; p0_transpose_item<0>(A.in[I_W1] + (size_t)j * DM * DFF, DM, DFF, (bf16*)(F.ws + WS_W1) + (size_t)j * DFF * DM, 256, scr, r % T_W1, F.lane); continue; } r -= 4 * T_W1;
        { const int j = r / T_W2; p0_transpose_item<0>(A.in[I_W2] + (size_t)j * DFF * DM, DFF, DM, (bf16*)(F.ws + WS_W2) + (size_t)j * DM * DFF, 64, scr, r % T_W2, F.lane); }
    }
    __syncthreads();
    LAS float* condT = (LAS float*)F.lds;
    for (int idx = F.tid; idx < 9 * DM; idx += 512) { const int r = idx / DM, k = idx % DM; const float v = r < 8 ? A.in[I_C][r * DM + k] : A.in[I_CCTX][k]; condT[k * 12 + r] = v / (1.f + __expf(-v)); }
    __syncthreads();
    float* PART = (float*)(F.ws + WS_PART);
    for (int it = gw; it < 4 * 48 * 32; it += NGW) {
        const int layer = it / 1536, rem = it % 1536, cc = rem >> 5, kc = rem & 31;
        const float* wp = A.in[I_ADAW] + ((size_t)layer * DM + kc * 64) * NMOD + cc * 256 + 4 * F.lane;
        f32x4 acc[9];
#pragma unroll
        for (int r = 0; r < 9; ++r) acc[r] = (f32x4){0.f, 0.f, 0.f, 0.f};
#pragma unroll 8
        for (int k = 0; k < 64; ++k) {
            const f32x4 w = *(const GAS f32x4*)(wp + (size_t)k * NMOD);
            const LAS f32x4* cp = (const LAS f32x4*)(condT + (kc * 64 + k) * 12); const f32x4 c0 = cp[0], c1 = cp[1], c2 = cp[2];
            acc[0] += w * c0[0]; acc[1] += w * c0[1]; acc[2] += w * c0[2]; acc[3] += w * c0[3];
            acc[4] += w * c1[0]; acc[5] += w * c1[1]; acc[6] += w * c1[2]; acc[7] += w * c1[3]; acc[8] += w * c2[0];
        }
#pragma unroll
        for (int r = 0; r < 9; ++r) *(GAS f32x4*)(PART + (((size_t)kc * 4 + layer) * 9 + r) * NMOD + cc * 256 + 4 * F.lane) = acc[r];
    }
}
DI void p1_mods(Frame& F, const Args& A) {
    const float* PART = (const float*)(F.ws + WS_PART); float* MODS = (float*)(F.ws + WS_MODS);
    for (int i = blockIdx.x * 512 + F.tid; i < 4 * 9 * NMOD / 4; i += F.G * 512) {
        const int e = i * 4, l = e / (9 * NMOD), c = e % NMOD;
        f32x4 s = *(const GAS f32x4*)(A.in[I_ADAB] + l * NMOD + c);
        for (int kc = 0; kc < 32; ++kc) s += *(const GAS f32x4*)(PART + (size_t)kc * 4 * 9 * NMOD + e);
        *(GAS f32x4*)(MODS + e) = s;
    }
}
template <bool COPY> DI void norm_phase(Frame& F, const float* src_lat, const float* src_ctx, const float* gain, const float* mods, int sc_off, bool do_lat, const h16* part, const float* gate_ctx, bf16* Udst, float* ssl, float* ssc) {
    float* HC = (float*)(F.ws + WS_HC);
    f32x4 A[8]; int cur = -1;
    for (int i = (do_lat ? 0 : 128) + F.wave; i < 136; i += NWAVES) {
        const bool isc = i >= 128; const int row = isc ? ML + 8 * (int)blockIdx.x + (i - 128) : 128 * (int)blockIdx.x + i; const int bidx = isc ? 8 : (row >> 12);
        if (bidx != cur) { cur = bidx; const float* mp = mods + bidx * NMOD;
#pragma unroll
            for (int k = 0; k < 8; ++k) { const int c = 4 * F.lane + 256 * k; const f32x4 g = *(const GAS f32x4*)(gain + c), sc = *(const GAS f32x4*)(mp + sc_off + c); A[k] = g * (sc + 1.f); } }
        const float* xr = isc ? src_ctx + (size_t)(row - ML) * DM : src_lat + (size_t)row * DM;
        f32x4 v[8]; float ss = 0.f;
#pragma unroll
        for (int k = 0; k < 8; ++k) v[k] = *(const GAS f32x4*)(xr + 4 * F.lane + 256 * k);
        if (!COPY && isc && part) {
            const h16* pr = part + (size_t)(row - ML) * DM + 4 * F.lane; float* hr = HC + (size_t)(row - ML) * DM + 4 * F.lane;
#pragma unroll
            for (int k = 0; k < 8; ++k) { const f32x4 p0 = __builtin_convertvector(*(const GAS h16x4*)(pr + 256 * k), f32x4), p1 = __builtin_convertvector(*(const GAS h16x4*)(pr + (size_t)MC * DM + 256 * k), f32x4), p2 = __builtin_convertvector(*(const GAS h16x4*)(pr + (size_t)2 * MC * DM + 256 * k), f32x4), p3 = __builtin_convertvector(*(const GAS h16x4*)(pr + (size_t)3 * MC * DM + 256 * k), f32x4);
                const f32x4 gt = *(const GAS f32x4*)(gate_ctx + 4 * F.lane + 256 * k); v[k] = v[k] + gt * ((p0 + p1) + (p2 + p3)); *(GAS f32x4*)(hr + 256 * k) = v[k]; }
        }
#pragma unroll
        for (int k = 0; k < 8; ++k) ss += (v[k].x * v[k].x + v[k].y * v[k].y) + (v[k].z * v[k].z + v[k].w * v[k].w);
        ss = wave_sum(ss, F.lane);
        if (F.lane == 0) { if (isc) ssc[row - ML] = ss; else ssl[row] = ss; }
        if (COPY && !isc) { h16* dr = (h16*)(F.ws + WS_H16) + (size_t)row * DM;
#pragma unroll
            for (int k = 0; k < 8; ++k) *(GAS h16x4*)(dr + 4 * F.lane + 256 * k) = __builtin_convertvector(v[k], h16x4); }
        if (COPY && isc) { float* dr = HC + (size_t)(row - ML) * DM;
#pragma unroll
            for (int k = 0; k < 8; ++k) *(GAS f32x4*)(dr + 4 * F.lane + 256 * k) = v[k]; }
#pragma unroll
        for (int k = 0; k < 8; ++k) { const f32x4 o = v[k] * A[k]; u32x2v w; w.x = pkbf(o.x, o.y); w.y = pkbf(o.z, o.w); *(GAS u32x2v*)((GAS unsigned char*)Udst + pg8::ablk_byte(row, 4 * F.lane + 256 * k, DM)) = w; }
    }
}
DI void p2_bias(Frame& F) {
    const float* MODS = (const float*)(F.ws + WS_MODS);
    LAS unsigned char* SH = F.lds;
    constexpr int SHP = (2048 + 8) * 2;
    const int fr = F.lane & 15, g = F.lane >> 4;
    { const int p = blockIdx.x & 7;
        const int layer = p >> 1, t = p & 1, j = layer >> 1; const bool is_na = (layer & 1) != 0;
        const int N = t ? DFF : (is_na ? 6144 : ML_NPAD);
        const bf16* W = t ? (const bf16*)(F.ws + WS_W1) + (size_t)layer * DFF * DM : (is_na ? (const bf16*)(F.ws + WS_WNA_QKV) + (size_t)j * 6144 * DM : (const bf16*)(F.ws + WS_WML_IN) + (size_t)j * ML_NPAD * DM);
        float* BV = t ? (float*)(F.ws + WS_BVM1) + (size_t)layer * 9 * DFF : (float*)(F.ws + WS_BVIN) + (size_t)layer * 9 * ML_NPAD;
        const float* sh = MODS + (size_t)layer * 9 * NMOD + (t ? 3 * DM : 0);
        __syncthreads();
        for (int idx = F.tid; idx < 16 * 1024; idx += 512) { const int r = idx >> 10, k2 = idx & 1023; unsigned wv = 0u; if (r < 9) { const float* s2 = sh + (size_t)r * NMOD + 2 * k2; wv = pkbf(s2[0], s2[1]); } *(LAS unsigned*)(SH + r * SHP + k2 * 4) = wv; }
        __syncthreads();
        for (int cg = (int)(blockIdx.x >> 3) * NWAVES + F.wave; cg < N / 16; cg += (F.G >> 3) * NWAVES) {
            f32x4 acc = (f32x4){0.f, 0.f, 0.f, 0.f};
#pragma unroll 8
            for (int ks = 0; ks < 64; ++ks) { const bf16x8 bw = *(const GAS bf16x8*)((const GAS unsigned char*)W + pg8::bblk_byte(cg * 16 + fr, 32 * ks + 8 * g, DM)); const bf16x8 as = *(const LAS bf16x8*)(SH + fr * SHP + (32 * ks + 8 * g) * 2); acc = mfma16(as, bw, acc); }
#pragma unroll
            for (int i = 0; i < 4; ++i) { const int r = 4 * g + i; if (r < 9) BV[(size_t)r * N + cg * 16 + fr] = acc[i]; }
        }
    }
}
DI void ml_gate_tail(Frame& F, const bf16* U, const bf16* W, float* G, const float* bgate, const float* ssl, const float* ssc, const float* bv, int rank, int nr) {
    LAS unsigned char* BL = F.lds;
    asm volatile("s_waitcnt vmcnt(0)" ::: "memory"); __syncthreads();
    for (int idx = F.tid; idx < 8192; idx += 512) { const int cg = idx >> 12, ks = (idx >> 6) & 63, l = idx & 63;
        *(LAS bf16x8*)(BL + idx * 16) = *(const GAS bf16x8*)((const GAS unsigned char*)W + pg8::bblk_byte(6144 + cg * 16 + (l & 15), 32 * ks + 8 * (l >> 4), DM)); }
    __syncthreads();
    const int fr = F.lane & 15, g = F.lane >> 4, gw = rank * NWAVES + F.wave, ngw = nr * NWAVES;
    const unsigned loff = (unsigned)(((fr * 64 + g * 16) ^ ((fr >> 3) << 5)));
    const int nrg = (MT / 16 - gw + ngw - 1) / ngw, nblk = nrg * 4;
    bf16x8 a0[16], a1[16]; f32x4 acc0 = (f32x4){0.f, 0.f, 0.f, 0.f}, acc1 = acc0;
#define GT_LOAD(dst, q) do { const int rg_ = gw + ((q) >> 2) * ngw; const GAS unsigned char* p_ = (const GAS unsigned char*)U + ((size_t)(rg_ >> 3) * (DM >> 6) + ((q) & 3) * 8) * 16384 + (unsigned)(rg_ & 7) * 2048u + loff; \
        _Pragma("unroll") for (int i_ = 0; i_ < 16; ++i_) dst[i_] = *(const GAS bf16x8*)(p_ + (i_ >> 1) * 16384 + (i_ & 1) * 1024); } while (0)
#define GT_COMP(src, q) do { const int kb_ = ((q) & 3) * 16; \
        _Pragma("unroll") for (int i4_ = 0; i4_ < 16; i4_ += 4) { bf16x8 b_[8]; \
            _Pragma("unroll") for (int j_ = 0; j_ < 4; ++j_) { b_[2 * j_] = *(const LAS bf16x8*)(BL + ((kb_ + i4_ + j_) * 64 + F.lane) * 16); b_[2 * j_ + 1] = *(const LAS bf16x8*)(BL + ((64 + kb_ + i4_ + j_) * 64 + F.lane) * 16); } \
            __builtin_amdgcn_sched_barrier(0); \
            _Pragma("unroll") for (int j_ = 0; j_ < 4; ++j_) { acc0 = mfma16(src[i4_ + j_], b_[2 * j_], acc0); acc1 = mfma16(src[i4_ + j_], b_[2 * j_ + 1], acc1); } } } while (0)
    if (nblk > 0) GT_LOAD(a0, 0);
    for (int q = 0; q < nblk; q += 2) {
        GT_LOAD(a1, q + 1);
        GT_COMP(a0, q);
        if (q + 2 < nblk) GT_LOAD(a0, q + 2);
        GT_COMP(a1, q + 1);
        if ((q & 3) == 2) {
            const int rg = gw + (q >> 2) * ngw, row0 = rg * 16 + 4 * g, bidx = row0 < ML ? (row0 >> 12) : 8;
            const float* sp = row0 < ML ? ssl + row0 : ssc + (row0 - ML);
            const float bi0 = bv[(size_t)bidx * ML_NPAD + 6144 + fr] + bgate[fr], bi1 = bv[(size_t)bidx * ML_NPAD + 6144 + 16 + fr] + bgate[16 + fr];
            const bool isf0 = ((fr >> 3) & 1) != 0;
#pragma unroll
            for (int i = 0; i < 4; ++i) { const float rstd = __builtin_amdgcn_rsqf(sp[i] * (1.f / DM) + RMS_EPS);
                float x0 = (acc0[i] * rstd + bi0) * (1.f / 15.f), x1 = (acc1[i] * rstd + bi1) * (1.f / 15.f);
                x0 = 15.f * (1.f - 2.f * __builtin_amdgcn_rcpf(__expf(2.f * x0) + 1.f)); x1 = 15.f * (1.f - 2.f * __builtin_amdgcn_rcpf(__expf(2.f * x1) + 1.f));
                if (isf0) { x0 = fminf(x0, 0.f) - log1pf(__expf(-fabsf(x0))); x1 = fminf(x1, 0.f) - log1pf(__expf(-fabsf(x1))); }
                float* gp = G + (size_t)(row0 + i) * 32; gp[fr] = x0; gp[16 + fr] = x1; }
            acc0 = (f32x4){0.f, 0.f, 0.f, 0.f}; acc1 = acc0; }
    }
#undef GT_LOAD
#undef GT_COMP
}
DI void final_norm_phase(Frame& F, const Args& AR) {
    const int rpw = ML / F.G, rbase = blockIdx.x * rpw;
    f32x4 A[8];
#pragma unroll
    for (int k = 0; k < 8; ++k) A[k] = *(const GAS f32x4*)(AR.in[I_FNORM] + 4 * F.lane + 256 * k);
    for (int i = F.wave; i < rpw; i += NWAVES) {
        float* xr = F.out + (size_t)(rbase + i) * DM; const h16* hr = (const h16*)(F.ws + WS_H16) + (size_t)(rbase + i) * DM; f32x4 v[8]; float ss = 0.f;
#pragma unroll
        for (int k = 0; k < 8; ++k) { v[k] = __builtin_convertvector(*(const GAS h16x4*)(hr + 4 * F.lane + 256 * k), f32x4); ss += (v[k].x * v[k].x + v[k].y * v[k].y) + (v[k].z * v[k].z + v[k].w * v[k].w); }
        const float rstd = 1.f / sqrtf(wave_sum(ss, F.lane) * (1.f / DM) + RMS_EPS);
#pragma unroll
        for (int k = 0; k < 8; ++k) *(GAS f32x4*)(xr + 4 * F.lane + 256 * k) = v[k] * rstd * A[k];
    }
}
DI void readout_phase(Frame& F, const float* mlnorm) {
    const bf16* HF = (const bf16*)(F.ws + WS_HF); const bf16* HB = (const bf16*)(F.ws + WS_HB); const bf16* OG = (const bf16*)(F.ws + WS_MOG); bf16* U = (bf16*)(F.ws + WS_U);
    const int gw = blockIdx.x * NWAVES + F.wave, NGW = F.G * NWAVES;
    for (int row = gw; row < MT; row += NGW) {
        const size_t ro = (size_t)row * DM;
#pragma unroll
        for (int k = 0; k < 4; ++k) {
            const int c = 8 * F.lane + 512 * k;
            const u32x4v a = *(const GAS u32x4v*)(HF + ro + c), b = *(const GAS u32x4v*)(HB + ro + c), g = *(const GAS u32x4v*)(OG + ro + c);
            const f32x4 n0 = *(const GAS f32x4*)(mlnorm + c), n1 = *(const GAS f32x4*)(mlnorm + c + 4);
            float h[8]; float ss = 0.f;
#pragma unroll
            for (int j = 0; j < 4; ++j) { h[2 * j] = bf_lo(a[j]) + bf_lo(b[j]); h[2 * j + 1] = bf_hi(a[j]) + bf_hi(b[j]); ss += h[2 * j] * h[2 * j] + h[2 * j + 1] * h[2 * j + 1]; }
#pragma unroll
            for (int o = 1; o < 32; o <<= 1) ss += bperm(ss, F.lane ^ o);
            const float rstd = 1.f / sqrtf(ss * (1.f / 256.f) + RMS_EPS);
            u32x4v w;
#pragma unroll
            for (int j = 0; j < 4; ++j) { const float nlo = j < 2 ? n0[2 * j] : n1[2 * j - 4], nhi = j < 2 ? n0[2 * j + 1] : n1[2 * j - 3];
                w[j] = pkbf(h[2 * j] * rstd * nlo * bf_lo(g[j]), h[2 * j + 1] * rstd * nhi * bf_hi(g[j])); }
            *(GAS u32x4v*)((GAS unsigned char*)U + pg8::ablk_byte(row, c, DM)) = w;
        }
    }
}

DI void swap16(float& a, float& b) { asm volatile("s_nop 1\n\tv_permlane16_swap_b32 %0, %1" : "+v"(a), "+v"(b)); }
DI void swap32(float& a, float& b) { asm volatile("s_nop 1\n\tv_permlane32_swap_b32 %0, %1" : "+v"(a), "+v"(b)); }
DI float xor16_max(float v) { float a = v, b = v; swap16(a, b); return fmaxf(a, b); }
DI float xor32_max(float v) { float a = v, b = v; swap32(a, b); return fmaxf(a, b); }
DI float xor16_sum(float v) { float a = v, b = v; swap16(a, b); return a + b; }
DI float xor32_sum(float v) { float a = v, b = v; swap32(a, b); return a + b; }
constexpr int NA_PITCH = 272, NA_VPITCH = 288, NA_TILE = 64 * NA_VPITCH, NA_RPB_OFF = 4 * NA_TILE;
DI bf16x8 na_softmax(f32x4 (&s)[2], float& m_run, float& l_run, f32x4 (&o)[8]) {
    float mx = fmaxf(fmaxf(fmaxf(s[0][0], s[0][1]), fmaxf(s[0][2], s[0][3])), fmaxf(fmaxf(s[1][0], s[1][1]), fmaxf(s[1][2], s[1][3])));
    mx = xor16_max(mx); mx = xor32_max(mx);
    const float m_new = mx > m_run + 8.f ? mx : m_run;
    const bool moved = m_new != m_run;
    float ls = 0.f;
#pragma unroll
    for (int kg = 0; kg < 2; ++kg)
#pragma unroll
        for (int i = 0; i < 4; ++i) { const float p = ex2(s[kg][i] - m_new); s[kg][i] = p; ls += p; }
    if (__builtin_amdgcn_ballot_w64(moved) != 0ull) {
        const float alpha = ex2(m_run - m_new); l_run *= alpha;
#pragma unroll
        for (int d = 0; d < 8; ++d) o[d] = o[d] * alpha; }
    l_run += ls; m_run = m_new;
    u32x4v pw; pw.x = pkbf(s[0][0], s[0][1]); pw.y = pkbf(s[0][2], s[0][3]); pw.z = pkbf(s[1][0], s[1][1]); pw.w = pkbf(s[1][2], s[1][3]);
    return __builtin_bit_cast(bf16x8, pw);
}
DI void na_phase(Frame& F, const float* rpb, bool need_ctx) {
    const bf16* QKV = (const bf16*)(F.ws + WS_QKV); bf16* AO = (bf16*)(F.ws + WS_U);
    const int w = F.wave, lane = F.lane, fr = lane & 15, g = lane >> 4, tq = (lane >> 2) & 3, tp = lane & 3;
    LAS float* rpbs = (LAS float*)(F.lds + NA_RPB_OFF);
    const int nunits = 2048 + (need_ctx ? 128 : 0);
    for (int u = blockIdx.x; u < nunits; u += F.G) {
        int b, h, ntw, band_lo = 0, ra = 0, c = 0, rsA = 0, rsB = 0, cs = 0, cstart = 0; size_t qgA, qgB;
        if (u < 2048) { const int x = u & 7, rq = (u >> 3) & 15, y = u >> 7, bh = y * 8 + x; b = bh >> 4; h = bh & 15;
            const int r0 = 4 * rq; ra = r0 + 2 * (w >> 2); const int cb = w & 3; c = 16 * cb + fr; qgA = (size_t)b * SEQ + ra * 64 + c; qgB = qgA + 64;
            rsA = min(max(ra - 4, 0), 56); rsB = min(max(ra - 3, 0), 56); band_lo = min(max(r0 - 4, 0), 56); const int band_hi = min(max(r0 - 1, 0), 56) + 7; ntw = band_hi - band_lo + 1;
            cstart = min(max(c - 8, 0), 48); cs = cb == 0 ? 0 : (cb == 1 ? 8 : (cb == 2 ? 24 : 32));
        } else { const int uc = u - 2048; b = uc >> 4; h = uc & 15; qgA = (size_t)ML + b * CTXL + 32 * w + fr; qgB = qgA + 16; ntw = 0; }
        const int NT = ntw + 4;
        bf16x8 qfA[4], qfB[4];
#pragma unroll
        for (int ks = 0; ks < 4; ++ks) { qfA[ks] = *(const GAS bf16x8*)(QKV + qgA * 6144 + h * 128 + 32 * ks + 8 * g); qfB[ks] = *(const GAS bf16x8*)(QKV + qgB * 6144 + h * 128 + 32 * ks + 8 * g); }
        if (ntw) for (int i = F.tid; i < 466; i += 512) rpbs[i] = i < 465 ? rpb[h * 465 + i] * LOG2E : -INFINITY;
        int boff[8]; int bvalid = 0;
#pragma unroll
        for (int k = 0; k < 8; ++k) { const int kc = cs + 16 * (k >> 2) + 4 * g + (k & 3); boff[k] = kc - c + 15; if (kc >= cstart && kc < cstart + 16) bvalid |= 1 << k; }
        f32x4 oA[8], oB[8];
#pragma unroll
        for (int d = 0; d < 8; ++d) { oA[d] = (f32x4){0.f, 0.f, 0.f, 0.f}; oB[d] = (f32x4){0.f, 0.f, 0.f, 0.f}; }
        float mA = -1e30f, lA = 0.f, mB = -1e30f, lB = 0.f;
        u32x4v pk[2], pv[2];
#define NA_TILE_BASE(tt) ((tt) < ntw ? (size_t)b * SEQ + (band_lo + (tt)) * 64 : (size_t)ML + b * CTXL + 64 * ((tt) - ntw))
#define NA_REQ(tt) do { const size_t base_ = NA_TILE_BASE(tt); _Pragma("unroll") for (int i = 0; i < 2; ++i) { const int id = F.tid + 512 * i, row = id >> 4, off = id & 15; \
            const bf16* p_ = QKV + (base_ + row) * 6144 + 2048 + h * 128 + off * 8; pk[i] = *(const GAS u32x4v*)p_; pv[i] = *(const GAS u32x4v*)(p_ + 2048); } } while (0)
#define NA_PUT(tt) do { LAS unsigned char* Kn_ = F.lds + ((tt) & 1) * 2 * NA_TILE; _Pragma("unroll") for (int i = 0; i < 2; ++i) { const int id = F.tid + 512 * i, row = id >> 4, off = id & 15; \
            *(LAS u32x4v*)(Kn_ + row * NA_PITCH + off * 16) = pk[i]; *(LAS u32x4v*)(Kn_ + NA_TILE + row * NA_VPITCH + off * 16) = pv[i]; } } while (0)
        NA_REQ(0); NA_PUT(0);
        __syncthreads();
        for (int t = 0; t < NT; ++t) {
            LAS unsigned char* Kb = F.lds + (t & 1) * 2 * NA_TILE; LAS unsigned char* Vb = Kb + NA_TILE;
            if (t + 1 < NT) NA_REQ(t + 1);
            const bool win = t < ntw; const int kr = band_lo + t;
            const bool actA = !win || (kr >= rsA && kr <= rsA + 7), actB = !win || (kr >= rsB && kr <= rsB + 7);
            if (actA || actB) {
                const int nstep = win ? 1 : 2; const int browA = (kr - ra + 7) * 31, browB = browA - 31;
#define NA_STEP(DOA, DOB) do { \
                    const int ko = win ? cs : 32 * st; \
                    f32x4 sA[2], sB[2]; \
                    _Pragma("unroll") for (int kg = 0; kg < 2; ++kg) { sA[kg] = (f32x4){0.f, 0.f, 0.f, 0.f}; sB[kg] = (f32x4){0.f, 0.f, 0.f, 0.f}; } \
                    if (win) { _Pragma("unroll") for (int k = 0; k < 8; ++k) { const bool v = (bvalid >> k) & 1; sA[k >> 2][k & 3] = rpbs[v && actA ? browA + boff[k] : 465]; sB[k >> 2][k & 3] = rpbs[v && actB ? browB + boff[k] : 465]; } } \
                    { bf16x8 kf[2][4]; \
                      _Pragma("unroll") for (int kg = 0; kg < 2; ++kg) _Pragma("unroll") for (int ks = 0; ks < 4; ++ks) kf[kg][ks] = *(const LAS bf16x8*)(Kb + (ko + 16 * kg + fr) * NA_PITCH + (32 * ks + 8 * g) * 2); \
                      _Pragma("unroll") for (int kg = 0; kg < 2; ++kg) _Pragma("unroll") for (int ks = 0; ks < 4; ++ks) { if (DOA) sA[kg] = mfma16(kf[kg][ks], qfA[ks], sA[kg]); if (DOB) sB[kg] = mfma16(kf[kg][ks], qfB[ks], sB[kg]); } } \
                    __builtin_amdgcn_sched_barrier(0); \
                    bf16x8 pbA, pbB; bf16x8 vf[8]; \
                    _Pragma("unroll") for (int d = 0; d < 8; ++d) { const s16x4 lo = tr_read(Vb + (ko + 4 * g + tq) * NA_VPITCH + 32 * d + 8 * tp), hi = tr_read(Vb + (ko + 16 + 4 * g + tq) * NA_VPITCH + 32 * d + 8 * tp); vf[d] = cat8(lo, hi); } \
                    pbA = na_softmax(sA, mA, lA, oA); \
                    __builtin_amdgcn_sched_barrier(0); \
                    _Pragma("unroll") for (int d = 0; d < 8; ++d) oA[d] = mfma16(vf[d], pbA, oA[d]);     \
                    __builtin_amdgcn_sched_barrier(0); \
                    pbB = na_softmax(sB, mB, lB, oB); \
                    __builtin_amdgcn_sched_barrier(0); \
                    _Pragma("unroll") for (int d = 0; d < 8; ++d) oB[d] = mfma16(vf[d], pbB, oB[d]); \
                    __builtin_amdgcn_sched_barrier(0); } while (0)
                for (int st = 0; st < nstep; ++st) {
                    NA_STEP(1, 1);
                }
#undef NA_STEP
            }
            if (t + 1 < NT) { NA_PUT(t + 1);
#ifdef NA_DUP_STAGE
              asm volatile("" ::: "memory"); NA_PUT(t + 1);
#endif
            }
#ifdef NA_DUP_BAR
            __syncthreads();
#endif
            __syncthreads();
        }
#undef NA_TILE_BASE
#undef NA_REQ
#undef NA_PUT
        { const float inv = 1.f / xor32_sum(xor16_sum(lA));
#pragma unroll
          for (int d = 0; d < 8; ++d) { u32x2v wv; wv.x = pkbf(oA[d][0] * inv, oA[d][1] * inv); wv.y = pkbf(oA[d][2] * inv, oA[d][3] * inv); *(GAS u32x2v*)((GAS unsigned char*)AO + pg8::ablk_byte((int)qgA, h * 128 + 16 * d + 4 * g, DM)) = wv; } }
        { const float inv = 1.f / xor32_sum(xor16_sum(lB));
#pragma unroll
          for (int d = 0; d < 8; ++d) { u32x2v wv; wv.x = pkbf(oB[d][0] * inv, oB[d][1] * inv); wv.y = pkbf(oB[d][2] * inv, oB[d][3] * inv); *(GAS u32x2v*)((GAS unsigned char*)AO + pg8::ablk_byte((int)qgB, h * 128 + 16 * d + 4 * g, DM)) = wv; } }
    }
}

constexpr int SC_P = 272, SC_BUF = 52224, SC_KO = 17408, SC_VO = 34816, SC_S = 104448, SC_SP = 144, SC_TB0 = 113664, SC_TBS = 1536;
constexpr int SC_NF = 116736, SC_NBF = 117248, SC_QN = 117504, SC_RS = 118016;
constexpr int T_E2 = 0, T_M2 = 256, T_WST = 512, T_NMS = 768, T_WK = 1024, T_SCAL = 1280;
constexpr size_t WS_GT = WS_END + 1 * MiB;
DI float rdlane(float v, int l) { return __builtin_bit_cast(float, __builtin_amdgcn_readlane(__builtin_bit_cast(int, v), l)); }
DI float ld_sc1(const float* p) { return __builtin_bit_cast(float, __hip_atomic_load((const unsigned*)p, __ATOMIC_RELAXED, __HIP_MEMORY_SCOPE_AGENT)); }
DI size_t scan_row(int b, int dir, int q) { return q < 4 ? (size_t)ML + b * CTXL + 64 * (dir ? 3 - q : q) : (size_t)b * SEQ + 64 * (dir ? 63 - (q - 4) : (q - 4)); }
DI void scan_phase(Frame& F) {
    const bf16* Qg = (const bf16*)(F.ws + WS_MQ); const bf16* Kg = (const bf16*)(F.ws + WS_MK); const bf16* Vg = (const bf16*)(F.ws + WS_MV); const float* Gg = (const float*)(F.ws + WS_MG);
    const int w = F.wave, lane = F.lane, fr = lane & 15, g = lane >> 4, tq = (lane >> 2) & 3, tp = lane & 3;
    LAS unsigned char* L = F.lds;
    for (int u = blockIdx.x; u < 256; u += F.G) {
        const int x = u & 7, y = u >> 3, eh = y & 1, pi = (y >> 1) * 8 + x, dir = pi & 1, bh = pi >> 1, b = bh >> 3, hd = bh & 7;
        bf16* Hg = (bf16*)(F.ws + (dir ? WS_HB : WS_HF));
        float* GT = (float*)(F.ws + WS_GT) + (size_t)u * 68 * 384;
        { LAS float* TB = (LAS float*)L; LAS float* TE = TB + 68 * 64; LAS float* TPM = TE + 68 * 64; LAS float* BT = TPM + 68 * 64; LAS float* EM = BT + 68; LAS float* MC = EM + 68;
          { const int o = dir ? 63 - lane : lane;
            float gi[9], gf[9];
#pragma unroll
            for (int k = 0; k < 9; ++k) { const int c = w + 8 * k; if (c < 68) { const float* gp = Gg + (scan_row(b, dir, c) + o) * 32 + dir * 16 + hd; gi[k] = gp[0]; gf[k] = gp[8]; } else { gi[k] = 0.f; gf[k] = 0.f; } }
#pragma unroll
            for (int k = 0; k < 9; ++k) { const int c = w + 8 * k; if (c < 68) { float bcs = gf[k];
#pragma unroll
                for (int d = 1; d < 64; d <<= 1) { const float t = bperm(bcs, lane - d); if (lane >= d) bcs += t; }
                const float e = gi[k] - bcs; float pm = e;
#pragma unroll
                for (int d = 1; d < 64; d <<= 1) { const float t = bperm(pm, lane - d); if (lane >= d) pm = fmaxf(pm, t); }
                TB[c * 64 + o] = bcs; TE[c * 64 + o] = e; TPM[c * 64 + o] = pm; if (lane == 63) { BT[c] = bcs; EM[c] = pm; } } } }
          __syncthreads();
          if (w == 0) {
              const float a0 = BT[lane], e0 = EM[lane], a1 = lane < 4 ? BT[64 + lane] : 0.f, e1 = lane < 4 ? EM[64 + lane] : 0.f;
              float m = 0.f, mc0 = 0.f, mc1 = 0.f;
#pragma unroll
              for (int c = 0; c < 64; ++c) { mc0 = lane == c ? m : mc0; m = rdlane(a0, c) + fmaxf(m, rdlane(e0, c)); }
#pragma unroll
              for (int c = 0; c < 4; ++c) { mc1 = lane == c ? m : mc1; m = rdlane(a1, c) + fmaxf(m, rdlane(e1, c)); }
              MC[lane] = mc0; if (lane < 4) MC[64 + lane] = mc1; }
          __syncthreads();
          for (int idx = F.tid; idx < 68 * 64; idx += 512) { const int c = idx >> 6, o = idx & 63; const float m = MC[c], Ml = fmaxf(m, EM[c]), bb = TB[idx], e = TE[idx], M = fmaxf(m, TPM[idx]);
              float* gt = GT + c * 384 + o; gt[0] = e * LOG2E; gt[64] = M * LOG2E; gt[128] = __expf(m - M); gt[192] = -(bb + M) * LOG2E; gt[256] = __expf(e - Ml); if (o == 0) gt[320] = __expf(m - Ml); }
          asm volatile("s_waitcnt vmcnt(0)" ::: "memory"); __syncthreads(); }
        f32x4 C[8];
#pragma unroll
        for (int d = 0; d < 8; ++d) C[d] = (f32x4){0.f, 0.f, 0.f, 0.f};
        if (F.tid < 128) { ((LAS float*)(L + SC_NF))[F.tid] = 0.f; ((LAS unsigned short*)(L + SC_NBF))[F.tid] = 0; }
        u32x4v pq[2], pk[2], pv[2]; float tb[6];
#define SC_REQUEST(qq) do { const size_t r1_ = scan_row(b, dir, (qq)); \
        _Pragma("unroll") for (int i = 0; i < 2; ++i) { const int id = F.tid + 512 * i, row = id >> 4, off = id & 15; \
            pq[i] = *(const GAS u32x4v*)(Qg + (r1_ + row) * 1024 + hd * 128 + off * 8); pk[i] = *(const GAS u32x4v*)(Kg + (r1_ + row) * 1024 + hd * 128 + off * 8); \
            pv[i] = *(const GAS u32x4v*)(Vg + (r1_ + row) * 2048 + hd * 256 + eh * 128 + off * 8); } \
        if (w == 0) { const float* gt = GT + (qq) * 384 + lane; _Pragma("unroll") for (int k = 0; k < 5; ++k) tb[k] = ld_sc1(gt + 64 * k); tb[5] = ld_sc1(GT + (qq) * 384 + 320); } } while (0)
#define SC_STAGE(bufi) do { LAS unsigned char* B_ = L + (bufi) * SC_BUF; \
        _Pragma("unroll") for (int i = 0; i < 2; ++i) { const int id = F.tid + 512 * i, row = id >> 4, off = id & 15; \
            *(LAS u32x4v*)(B_ + row * SC_P + off * 16) = pq[i]; *(LAS u32x4v*)(B_ + SC_KO + row * SC_P + off * 16) = pk[i]; *(LAS u32x4v*)(B_ + SC_VO + row * SC_P + off * 16) = pv[i]; } \
        if (w == 0) { LAS float* T_ = (LAS float*)(L + SC_TB0 + (bufi) * SC_TBS); _Pragma("unroll") for (int k = 0; k < 5; ++k) T_[64 * k + lane] = tb[k]; if (lane == 0) T_[320] = tb[5]; } } while (0)
        SC_REQUEST(0); SC_STAGE(0); SC_REQUEST(1);
        __syncthreads();
        for (int q = 0; q < 68; ++q) {
            const int cur = q & 1; int bo_ = cur * SC_BUF, to_ = SC_TB0 + cur * SC_TBS; asm volatile("" : "+s"(bo_), "+s"(to_));
            LAS unsigned char* Bq = L + bo_; LAS unsigned char* Tq = L + to_; int so_ = SC_S; asm volatile("" : "+s"(so_)); LAS unsigned char* Lq = L + so_ - SC_S;
            const size_t row0 = scan_row(b, dir, q);
#ifdef SCAN_DUP_A
            _Pragma("unroll 1") for (int dupa = 0; dupa < 2; ++dupa)
#endif
            { const int st = w & 3, jh = w >> 2; asm volatile("" ::: "memory");
              bf16x8 qf[4];
#pragma unroll
              for (int ks = 0; ks < 4; ++ks) qf[ks] = *(const LAS bf16x8*)(Bq + (16 * st + fr) * SC_P + (32 * ks + 8 * g) * 2);
              const float Ms = ((const LAS float*)(Tq + T_M2))[16 * st + fr];
#pragma unroll
              for (int jj = 0; jj < 2; ++jj) { const int jt = 2 * jh + jj; f32x4 a = (f32x4){0.f, 0.f, 0.f, 0.f};
#pragma unroll
                  for (int ks = 0; ks < 4; ++ks) { const bf16x8 kf = *(const LAS bf16x8*)(Bq + SC_KO + (16 * jt + fr) * SC_P + (32 * ks + 8 * g) * 2); a = mfma16(kf, qf[ks], a); }
                  const f32x4 e4 = *(const LAS f32x4*)(Tq + T_E2 + (16 * jt + 4 * g) * 4); float rs = 0.f;
#pragma unroll
                  for (int i = 0; i < 4; ++i) { const int j = 16 * jt + 4 * g + i, s = 16 * st + fr; const bool causal = dir ? (j >= s) : (j <= s);
                      const float wgt = causal ? ex2(e4[i] - Ms) : 0.f; a[i] = a[i] * wgt; rs += a[i]; }
                  rs = xor32_sum(xor16_sum(rs));
                  if (g == 0) ((LAS float*)(Lq + SC_RS))[jt * 64 + 16 * st + fr] = rs;
                  u32x2v sw; sw.x = pkbf(a[0], a[1]); sw.y = pkbf(a[2], a[3]);
                  *(LAS u32x2v*)(Lq + SC_S + (16 * st + fr) * SC_SP + (16 * jt + 4 * g) * 2) = sw; }
              { f32x4 a = (f32x4){0.f, 0.f, 0.f, 0.f};
#pragma unroll
                for (int kk = 0; kk < 2; ++kk) { const int ks = 2 * jh + kk; const bf16x8 nf = *(const LAS bf16x8*)(Lq + SC_NBF + (32 * ks + 8 * g) * 2); const bf16x8 qk = *(const LAS bf16x8*)(Bq + (16 * st + fr) * SC_P + (32 * ks + 8 * g) * 2); a = mfma16(nf, qk, a); }
                if (g == 0) ((LAS float*)(Lq + SC_QN))[jh * 64 + 16 * st + fr] = a[0]; } }
            __syncthreads();
            if (q + 1 < 68) { SC_STAGE(cur ^ 1);
#ifdef SCAN_DUP_STAGE
              asm volatile("" ::: "memory"); SC_STAGE(cur ^ 1);
#endif
            }
#define SC_LDQA(dst, s4) do { const LAS unsigned char* qp_ = Bq + (16 * (s4) + fr) * SC_P; _Pragma("unroll") for (int ks = 0; ks < 4; ++ks) { \
                const u32x2v lo_ = *(const LAS u32x2v*)(qp_ + (32 * ks + 4 * g) * 2), hi_ = *(const LAS u32x2v*)(qp_ + (32 * ks + 16 + 4 * g) * 2); \
                u32x4v aw_; aw_.x = lo_.x; aw_.y = lo_.y; aw_.z = hi_.x; aw_.w = hi_.y; dst[ks] = __builtin_bit_cast(bf16x8, aw_); } } while (0)
#define SC_LDKT(dst, d) do { _Pragma("unroll") for (int k2 = 0; k2 < 2; ++k2) { const s16x4 lo_ = tr_read(Bq + SC_KO + (32 * k2 + 8 * g + tq) * SC_P + 32 * (d) + 8 * tp), hi_ = tr_read(Bq + SC_KO + (32 * k2 + 8 * g + 4 + tq) * SC_P + 32 * (d) + 8 * tp); dst[k2] = cat8(lo_, hi_); } } while (0)
            bf16x8 vf[2];
#pragma unroll
            for (int k2 = 0; k2 < 2; ++k2) { const s16x4 lo = tr_read(Bq + SC_VO + (32 * k2 + 8 * g + tq) * SC_P + 32 * w + 8 * tp), hi = tr_read(Bq + SC_VO + (32 * k2 + 8 * g + 4 + tq) * SC_P + 32 * w + 8 * tp); vf[k2] = cat8(lo, hi); }
            bf16x8 qa0[4], qa1[4], qa2[4], qa3[4];
            SC_LDQA(qa0, 0); SC_LDQA(qa1, 1);
            bf16x8 cb[4];
#pragma unroll
            for (int ks = 0; ks < 4; ++ks) { u32x4v cw; cw.x = pkbf(C[2 * ks][0], C[2 * ks][1]); cw.y = pkbf(C[2 * ks][2], C[2 * ks][3]); cw.z = pkbf(C[2 * ks + 1][0], C[2 * ks + 1][1]); cw.w = pkbf(C[2 * ks + 1][2], C[2 * ks + 1][3]); cb[ks] = __builtin_bit_cast(bf16x8, cw); }
            SC_LDQA(qa2, 2); SC_LDQA(qa3, 3);
            __builtin_amdgcn_sched_barrier(0);
            f32x4 yv[4];
#pragma unroll
            for (int s4 = 0; s4 < 4; ++s4) yv[s4] = (f32x4){0.f, 0.f, 0.f, 0.f};
#pragma unroll
            for (int ks = 0; ks < 4; ++ks) { yv[0] = mfma16(cb[ks], qa0[ks], yv[0]); yv[1] = mfma16(cb[ks], qa1[ks], yv[1]); }
            bf16x8 sf[4][2];
#pragma unroll
            for (int s4 = 0; s4 < 4; ++s4)
#pragma unroll
                for (int k2 = 0; k2 < 2; ++k2) sf[s4][k2] = *(const LAS bf16x8*)(Lq + SC_S + (16 * s4 + fr) * SC_SP + (32 * k2 + 8 * g) * 2);
            __builtin_amdgcn_sched_barrier(0);
#pragma unroll
            for (int ks = 0; ks < 4; ++ks) { yv[2] = mfma16(cb[ks], qa2[ks], yv[2]); yv[3] = mfma16(cb[ks], qa3[ks], yv[3]); }
            float qn[4], rsum[4], wst[4], nm[4];
#pragma unroll
            for (int s4 = 0; s4 < 4; ++s4) { const int s = 16 * s4 + fr;
                qn[s4] = ((const LAS float*)(Lq + SC_QN))[s] + ((const LAS float*)(Lq + SC_QN))[64 + s];
                rsum[s4] = (((const LAS float*)(Lq + SC_RS))[s] + ((const LAS float*)(Lq + SC_RS))[64 + s]) + (((const LAS float*)(Lq + SC_RS))[128 + s] + ((const LAS float*)(Lq + SC_RS))[192 + s]);
                wst[s4] = ((const LAS float*)(Tq + T_WST))[s]; nm[s4] = ((const LAS float*)(Tq + T_NMS))[s]; }
            bf16x8 kta[4][2];
#pragma unroll
            for (int d = 0; d < 4; ++d) SC_LDKT(kta[d], d);
            __builtin_amdgcn_sched_barrier(0);
            bf16* hrow = Hg + (row0 + fr) * DM + hd * 256 + eh * 128 + 16 * w + 4 * g;
#pragma unroll
            for (int s4 = 0; s4 < 4; ++s4) {
                yv[s4] = yv[s4] * wst[s4];
#pragma unroll
                for (int k2 = 0; k2 < 2; ++k2) yv[s4] = mfma16(vf[k2], sf[s4][k2], yv[s4]);
                const float den = wst[s4] * qn[s4] + rsum[s4], rinv = __builtin_amdgcn_rcpf(fmaxf(fabsf(den), ex2(nm[s4])));
                u32x2v hw; hw.x = pkbf(yv[s4][0] * rinv, yv[s4][1] * rinv); hw.y = pkbf(yv[s4][2] * rinv, yv[s4][3] * rinv);
                *(GAS u32x2v*)(hrow + (size_t)(16 * s4) * DM) = hw;
            }
            const float decay = ((const LAS float*)(Tq + T_SCAL))[0];
            bf16x8 vw[2], wkf[2];
#pragma unroll
            for (int k2 = 0; k2 < 2; ++k2) { const f32x4 wa = *(const LAS f32x4*)(Tq + T_WK + (32 * k2 + 8 * g) * 4), wb = *(const LAS f32x4*)(Tq + T_WK + (32 * k2 + 8 * g + 4) * 4);
                const u32x4v vu = __builtin_bit_cast(u32x4v, vf[k2]); u32x4v o, ww;
                o.x = pkbf(bf_lo(vu.x) * wa[0], bf_hi(vu.x) * wa[1]); o.y = pkbf(bf_lo(vu.y) * wa[2], bf_hi(vu.y) * wa[3]); o.z = pkbf(bf_lo(vu.z) * wb[0], bf_hi(vu.z) * wb[1]); o.w = pkbf(bf_lo(vu.w) * wb[2], bf_hi(vu.w) * wb[3]);
                ww.x = pkbf(wa[0], wa[1]); ww.y = pkbf(wa[2], wa[3]); ww.z = pkbf(wb[0], wb[1]); ww.w = pkbf(wb[2], wb[3]);
                vw[k2] = __builtin_bit_cast(bf16x8, o); wkf[k2] = __builtin_bit_cast(bf16x8, ww); }
            bf16x8 ktb[4][2], ktn[2];
#pragma unroll
            for (int d = 0; d < 4; ++d) SC_LDKT(ktb[d], d + 4);
            SC_LDKT(ktn, w);
            __builtin_amdgcn_sched_barrier(0);
#pragma unroll
            for (int d = 0; d < 4; ++d) { C[d] = C[d] * decay;
#pragma unroll
                for (int k2 = 0; k2 < 2; ++k2) C[d] = mfma16(kta[d][k2], vw[k2], C[d]); }
            __builtin_amdgcn_sched_barrier(0);
#pragma unroll
            for (int d = 0; d < 4; ++d) { C[d + 4] = C[d + 4] * decay;
#pragma unroll
                for (int k2 = 0; k2 < 2; ++k2) C[d + 4] = mfma16(ktb[d][k2], vw[k2], C[d + 4]); }
            f32x4 nacc = (f32x4){0.f, 0.f, 0.f, 0.f};
#pragma unroll
            for (int k2 = 0; k2 < 2; ++k2) nacc = mfma16(ktn[k2], wkf[k2], nacc);
            if (fr == 0) { LAS float* nfp = (LAS float*)(Lq + SC_NF) + 16 * w + 4 * g; const f32x4 nold = *(LAS f32x4*)nfp; const f32x4 nn = nold * decay + nacc; *(LAS f32x4*)nfp = nn;
                u32x2v nb; nb.x = pkbf(nn[0], nn[1]); nb.y = pkbf(nn[2], nn[3]); *(LAS u32x2v*)(Lq + SC_NBF + (16 * w + 4 * g) * 2) = nb; }
            if (q + 2 < 68) SC_REQUEST(q + 2);
#undef SC_LDQA
#undef SC_LDKT
            __syncthreads();
        }
#undef SC_REQUEST
#undef SC_STAGE
    }
}


constexpr int N_PHASES = 3 + 8 * DEPTH + 1;
#ifndef REP_P0
#define REP_P0 1
#endif
#ifndef REP_SCAN
#define REP_SCAN 1
#endif
#ifndef REP_NA
#define REP_NA 1
#endif
#ifndef REP_NORM
#define REP_NORM 1
#endif
#ifndef REP_RO
#define REP_RO 1
#endif
#ifndef REP_MLP1
#define REP_MLP1 1
#endif
#ifndef PROBE_DUMMY
#define PROBE_DUMMY 0
#endif
#ifndef PROBE_LAYER_MASK
#define PROBE_LAYER_MASK 15
#endif
#ifndef DBG_DEPTH
#define DBG_DEPTH DEPTH
#endif
__global__ void __launch_bounds__(NWAVES * 64, 2) fwd(Args args) {
    extern __shared__ __attribute__((aligned(16))) unsigned char lds[];
    Frame F;
    F.lds = (LAS unsigned char*)lds; F.tid = threadIdx.x; F.lane = F.tid & 63; F.wave = __builtin_amdgcn_readfirstlane(F.tid >> 6); F.G = gridDim.x;
    F.out = args.out; F.ws = args.ws;
    volatile LAS unsigned* MISC = (volatile LAS unsigned*)(F.lds + MISC_OFF);
    for (int u = F.tid; u < (LDS_BYTES - LDSCTL_OFF) / 4; u += NWAVES * 64) ((LAS unsigned*)(F.lds + LDSCTL_OFF))[u] = 0u;
    __syncthreads();
    const int wave_s = __builtin_amdgcn_readfirstlane(threadIdx.x >> 6);
    const int lo = args.ph_lo, hi = args.ph_hi;
    unsigned* barw = (unsigned*)(F.ws + WS_CTL) + CW_BAR + args.li * XCD_BAR_WORDS;
    XcdBarrier bar; bar.bar = barw; bar.x = 0; bar.st = nullptr;
    if (hi - lo > 1) bar = xcd_barrier_post(barw, MISC + 8);
#define FRESH() do { int wv_ = wave_s; asm volatile("" : "+s"(wv_)); unsigned z_ = 0u; asm volatile("" : "+s"(z_)); int l_ = (int)__builtin_amdgcn_mbcnt_hi(~0u, __builtin_amdgcn_mbcnt_lo(~0u, z_)); asm volatile("" : "+v"(l_)); F.lane = l_; F.wave = wv_; F.tid = wv_ * 64 + l_; \
    size_t zo_ = 0; asm volatile("" : "+s"(zo_)); F.ws = args.ws + zo_; F.out = args.out + zo_; } while (0)
#ifdef PROBE_XLOAD
#define XPROBE_SET E.xprobe = args.in[I_X]
#else
#define XPROBE_SET
#endif
#ifndef WGM_RES
#define WGM_RES 4
#endif
#define RUN(k) (lo <= (k) && (k) < hi)
#ifdef PROBE_WAIT
    unsigned long long wait_acc = 0ull;
#define SEAM(k) do { if (RUN(k) && RUN((k) + 1)) { const unsigned long long t0_ = __builtin_amdgcn_s_memrealtime(); xcd_barrier(bar); if (PROBE_WAIT < 0 || ((k) >= 3 && ((k) - 3) % 8 == PROBE_WAIT)) wait_acc += __builtin_amdgcn_s_memrealtime() - t0_; } } while (0)
#else
#define SEAM(k) do { if (RUN(k) && RUN((k) + 1)) xcd_barrier(bar); } while (0)
#endif
    LAS unsigned char* ring = F.lds;
#define U ((bf16*)(F.ws + WS_U))
#define HC ((float*)(F.ws + WS_HC))
#define MODS ((const float*)(F.ws + WS_MODS))
#define U2 ((bf16*)(void*)F.out)
#define H16 ((h16*)(F.ws + WS_H16))
#define SSL_A ((float*)(F.ws + WS_CTL + CTL_SSL_A))
#define SSL_B ((float*)(F.ws + WS_CTL + CTL_SSL_B))
#define SSC_A ((float*)(F.ws + WS_CTL + CTL_SSC_A))
#define SSC_B ((float*)(F.ws + WS_CTL + CTL_SSC_B))
#define ZERO_SS(p) do { if (F.tid < 128) (p)[128 * (int)blockIdx.x + F.tid] = 0.f; } while (0)

    #ifndef NO_P0
    if (RUN(0)) { _Pragma("unroll 1") for (int rep = 0; rep < REP_P0; ++rep) { FRESH(); p0_prologue(F, args); __syncthreads(); } }
#endif
    SEAM(0);
    if (RUN(1)) { FRESH(); p1_mods(F, args); } SEAM(1);
    if (RUN(2)) { FRESH(); p2_bias(F); }

    for (int layer = 0; layer < DBG_DEPTH; ++layer) {
        const int pb = 3 + 8 * layer, j = layer >> 1; const bool is_na = (layer & 1) != 0, need_ctx = layer < DEPTH - 1;
        const int mrows = need_ctx ? MT : ML;
#define mods (MODS + (size_t)layer * 9 * NMOD)
        if (RUN(pb + 0)) { _Pragma("unroll 1") for (int rep = 0; rep < REP_NORM; ++rep) { FRESH();
            if (layer == 0) norm_phase<true>(F, args.in[I_X], args.in[I_CTX], args.in[I_NMIX], mods, DM, true, nullptr, nullptr, U, SSL_B, SSC_B);
            else norm_phase<false>(F, F.out, HC, args.in[I_NMIX] + layer * DM, mods, DM, false, (const h16*)(F.ws + WS_PC), MODS + ((size_t)(layer - 1) * 9 + 8) * NMOD + 5 * DM, U, SSL_B, SSC_B); } }
        SEAM(pb + 0);
        if (RUN(pb + 1)) { FRESH();
            if (!is_na) {
                pg8::Gemm g{U, (const bf16*)(F.ws + WS_WML_IN) + (size_t)j * ML_NPAD * DM, MT, ML_NPAD, DM, DM, 1, 1}; pg8::Order8 S; S.init(MT, 6144, F.G, (int)blockIdx.x); S.rev = layer > 0;
                pg8::EpiMl E{(bf16*)(F.ws + WS_MQ), (bf16*)(F.ws + WS_MK), (bf16*)(F.ws + WS_MV), (bf16*)(F.ws + WS_MOG), (float*)(F.ws + WS_MG), args.in[I_MLBG] + j * 32, (const PG8_LAS unsigned char*)(F.lds + ROPE_LDS_OFF), pg8::NormIn{SSL_B, SSC_B, (const float*)(F.ws + WS_BVIN) + (size_t)layer * 9 * ML_NPAD, ML_NPAD}};
                { const f32x4* src = (const f32x4*)(F.ws + WS_ROPE); for (int e = F.tid; e < 1024; e += NWAVES * 64) *(LAS f32x4*)(F.lds + ROPE_LDS_OFF + (e >> 4) * ROPE_LDS_PITCH + (e & 15) * 16) = src[e]; __syncthreads(); }
#ifndef NO_G1
                pg8::gemm_phase<pg8::EpiMl, pg8::Order8, true, true>(ring, g, S, E, F.tid);
                if ((int)blockIdx.x >= 192) { FRESH();
                    ml_gate_tail(F, U, (const bf16*)(F.ws + WS_WML_IN) + (size_t)j * ML_NPAD * DM, (float*)(F.ws + WS_MG), args.in[I_MLBG] + j * 32, SSL_B, SSC_B, (const float*)(F.ws + WS_BVIN) + (size_t)layer * 9 * ML_NPAD, (int)blockIdx.x - 192, 64); }
#endif
            } else {
                pg8::Gemm g{U, (const bf16*)(F.ws + WS_WNA_QKV) + (size_t)j * 6144 * DM, MT, 6144, DM, DM, 1, 1}; pg8::Order8 S; S.init(MT, 6144, F.G, (int)blockIdx.x); S.rev = 1;
                pg8::EpiQKV E{(bf16*)(F.ws + WS_QKV), 6144, 8, 0.08838834764831845f * LOG2E, pg8::NormIn{SSL_B, SSC_B, (const float*)(F.ws + WS_BVIN) + (size_t)layer * 9 * ML_NPAD, 6144}};
#ifndef NO_G2
                pg8::gemm_phase<pg8::EpiQKV, pg8::Order8, true, true>(ring, g, S, E, F.tid);
#endif
            }
        }
        SEAM(pb + 1);
        if (RUN(pb + 2)) { FRESH();
#ifndef NO_SCAN
            if (!is_na) { _Pragma("unroll 1") for (int rep = 0; rep < REP_SCAN; ++rep) { FRESH(); scan_phase(F); } }
#endif
#ifndef NO_NA
            if (is_na) { _Pragma("unroll 1") for (int rep = 0; rep < REP_NA; ++rep) { FRESH(); na_phase(F, args.in[I_NARPB] + (size_t)j * 16 * 465, need_ctx); } }
#endif
        }
        SEAM(pb + 2);
        if (RUN(pb + 3)) { if (!is_na) { _Pragma("unroll 1") for (int rep = 0; rep < REP_RO; ++rep) { FRESH(); readout_phase(F, args.in[I_MLNORM] + j * DM); } } }
        if (!is_na) SEAM(pb + 3);
        if (RUN(pb + 4)) { FRESH();
            const bf16* wt = is_na ? (const bf16*)(F.ws + WS_WNA_OUT) + (size_t)j * DM * DM : (const bf16*)(F.ws + WS_WML_OUT) + (size_t)j * DM * DM;
            { pg8::Gemm g{U, wt, ML, DM, DM, DM, 1, 1}; pg8::Order8 S; S.init(ML, DM, F.G, (int)blockIdx.x); S.wgm = WGM_RES;
              ZERO_SS(SSL_B);
              pg8::EpiRes E{args.pad ? (h16*)(F.ws + WS_U) : H16, H16, mods, 2 * DM, args.pad, args.pad ? nullptr : U2, SSL_A, args.in[I_NMLP] + layer * DM, mods + 4 * DM};
              XPROBE_SET; pg8::gemm_phase<pg8::EpiRes, pg8::Order8, true, true>(ring, g, S, E, F.tid); }
            if (need_ctx) { FRESH(); pg8::Gemm g{U + (size_t)ML * DM, wt, MC, DM, DM / 4, DM, 1, 1}; pg8::SplitK4Order S{(int)blockIdx.x};
              pg8::EpiPart E{(h16*)(F.ws + WS_PC)};
              pg8::gemm_phase<pg8::EpiPart, pg8::SplitK4Order, true, true>(ring, g, S, E, F.tid); }
        }
        SEAM(pb + 4);
        if (RUN(pb + 5)) { _Pragma("unroll 1") for (int rep = 0; rep < REP_NORM; ++rep) { FRESH();
            if (need_ctx) norm_phase<false>(F, F.out, HC, args.in[I_NMLP] + layer * DM, mods, 4 * DM, false, (const h16*)(F.ws + WS_PC), mods + (size_t)8 * NMOD + 2 * DM, U2, SSL_A, SSC_A); } }
        if (need_ctx) SEAM(pb + 5);
        if (RUN(pb + 6)) { FRESH();
            pg8::Gemm g{U2, (const bf16*)(F.ws + WS_W1) + (size_t)layer * DFF * DM, mrows, DFF, DM, DM, 1, 1}; pg8::Order8 S; S.init(mrows, DFF, F.G, (int)blockIdx.x); S.rev = 1;
            pg8::EpiSqRelu E{(bf16*)(F.ws + WS_HID), DFF, pg8::NormIn{SSL_A, SSC_A, (const float*)(F.ws + WS_BVM1) + (size_t)layer * 9 * DFF, DFF}};
#ifndef NO_G4
            _Pragma("unroll 1") for (int rep = 0; rep < REP_MLP1; ++rep) { pg8::gemm_phase<pg8::EpiSqRelu, pg8::Order8, true, true>(ring, g, S, E, F.tid); }
#endif
        }
        SEAM(pb + 6);
        if (RUN(pb + 7)) { FRESH();
            const bf16* w2 = (const bf16*)(F.ws + WS_W2) + (size_t)layer * DM * DFF;
            { pg8::Gemm g{(const bf16*)(F.ws + WS_HID), w2, ML, DM, DFF, DFF, 1, 1}; pg8::Order8 S; S.init(ML, DM, F.G, (int)blockIdx.x); S.wgm = WGM_RES;
              ZERO_SS(SSL_A);
              const bool nxt = layer + 1 < DEPTH && !args.pad;
              pg8::EpiRes E{args.pad ? (h16*)(F.ws + WS_U) : H16, H16, mods, 5 * DM, args.pad, nxt ? U : nullptr, SSL_B, args.in[I_NMIX] + (layer + 1) * DM, MODS + (size_t)(layer + 1) * 9 * NMOD + DM};
              XPROBE_SET; pg8::gemm_phase<pg8::EpiRes, pg8::Order8, true, true>(ring, g, S, E, F.tid); }
            if (need_ctx) { FRESH(); pg8::Gemm g{(const bf16*)(F.ws + WS_HID) + (size_t)ML * DFF, w2, MC, DM, DFF / 4, DFF, 1, 1}; pg8::SplitK4Order S{(int)blockIdx.x};
              pg8::EpiPart E{(h16*)(F.ws + WS_PC)};
              pg8::gemm_phase<pg8::EpiPart, pg8::SplitK4Order, true, true>(ring, g, S, E, F.tid); }
        }
        SEAM(pb + 7);
    }
#undef mods
    if (RUN(N_PHASES - 1)) { FRESH(); final_norm_phase(F, args); }
#ifdef PROBE_WAIT
    if (hi - lo > 1) { unsigned long long* sum = (unsigned long long*)(F.ws + WS_CTL + 900 * 1024);
        if (threadIdx.x == 0) atomicAdd(sum, wait_acc);
        xcd_barrier(bar);
        const unsigned long long tot = __hip_atomic_load(sum, __ATOMIC_RELAXED, __HIP_MEMORY_SCOPE_AGENT) / 256ull, t0_ = __builtin_amdgcn_s_memrealtime();
        while (__builtin_amdgcn_s_memrealtime() - t0_ < tot) __builtin_amdgcn_s_sleep(8); }
#endif
#ifdef PROBE_EXTRA_BARRIERS
    if (hi - lo > 1) for (int xb = 0; xb < PROBE_EXTRA_BARRIERS; ++xb) xcd_barrier(bar);
#endif
#undef RUN
#undef U
#undef HC
#undef MODS
#undef U2
#undef H16
#undef SSL_A
#undef SSL_B
#undef SSC_A
#undef SSC_B
#undef ZERO_SS
#undef FRESH
#undef SEAM
}

extern "C" void kernel_launch(void* const* d_in, const int* in_sizes, int n_in, void* d_out, int out_size, void* d_ws, size_t ws_size, hipStream_t stream) {
    static int grid = 0;
    if (grid == 0) {
        if (n_in != 18 || out_size != ML * DM || ws_size < WS_TOTAL) { fprintf(stderr, "kernel_launch: built for 18 inputs, out of %d floats, >= %zu bytes of workspace; got n_in %d, out %d, ws %zu; nothing launched\n", ML * DM, (size_t)WS_TOTAL, n_in, out_size, ws_size); grid = -1; return; }
        int dev = 0, cus = 0, per_cu = 0;
        if (hipGetDevice(&dev) != hipSuccess || hipDeviceGetAttribute(&cus, hipDeviceAttributeMultiprocessorCount, dev) != hipSuccess) { fprintf(stderr, "kernel_launch: device query failed\n"); grid = -1; return; }
        if (hipFuncSetAttribute((const void*)fwd, hipFuncAttributeMaxDynamicSharedMemorySize, LDS_BYTES) != hipSuccess) { fprintf(stderr, "kernel_launch: hipFuncSetAttribute failed\n"); grid = -1; return; }
        if (hipOccupancyMaxActiveBlocksPerMultiprocessor(&per_cu, (const void*)fwd, NWAVES * 64, LDS_BYTES) != hipSuccess || per_cu < 1) fprintf(stderr, "kernel_launch: note: occupancy query reports %d workgroups per CU\n", per_cu);
        (void)hipGetLastError();
        if (cus < 256) { fprintf(stderr, "kernel_launch: needs 256 CUs (one resident workgroup each), device has %d; nothing launched\n", cus); grid = -1; return; }
        grid = 256;
    }
    if (grid < 0) return;
    if (hipMemsetAsync((char*)d_ws + WS_CTL, 0, CTL_ZERO_BYTES, stream) != hipSuccess) { fprintf(stderr, "kernel_launch: hipMemsetAsync failed\n"); return; }
    Args a{};
    for (int i = 0; i < 18; ++i) a.in[i] = (const float*)d_in[i];
    a.out = (float*)d_out; a.ws = (unsigned char*)d_ws;
#if MK_PER_PHASE
    for (int p = 0; p < N_PHASES; ++p) { a.ph_lo = p; a.ph_hi = p + 1; a.li = p; hipLaunchKernelGGL(fwd, dim3(grid), dim3(NWAVES * 64), LDS_BYTES, stream, a); }
#elif defined(PROBE_REP_LP)
    { int start = 0, li = 0;
      for (int layer = 0; layer < DEPTH; ++layer) { const int p = 3 + 8 * layer + PROBE_REP_LP;
          a.ph_lo = start; a.ph_hi = p + 1; a.li = li++; hipLaunchKernelGGL(fwd, dim3(grid), dim3(NWAVES * 64), LDS_BYTES, stream, a);
          if ((PROBE_LAYER_MASK >> layer) & 1) { a.ph_lo = p; a.ph_hi = p + 1; a.li = li++; a.pad = PROBE_DUMMY; hipLaunchKernelGGL(fwd, dim3(grid), dim3(NWAVES * 64), LDS_BYTES, stream, a); a.pad = 0; } start = p + 1; }
      a.ph_lo = start; a.ph_hi = N_PHASES; a.li = li++; hipLaunchKernelGGL(fwd, dim3(grid), dim3(NWAVES * 64), LDS_BYTES, stream, a); }
#elif defined(PROBE_CUT_LP)
    { int start = 0, li = 0;
      for (int layer = 0; layer < DEPTH; ++layer) { const int p = 3 + 8 * layer + PROBE_CUT_LP;
          a.ph_lo = start; a.ph_hi = p + 1; a.li = li++; hipLaunchKernelGGL(fwd, dim3(grid), dim3(NWAVES * 64), LDS_BYTES, stream, a); start = p + 1; }
      a.ph_lo = start; a.ph_hi = N_PHASES; a.li = li++; hipLaunchKernelGGL(fwd, dim3(grid), dim3(NWAVES * 64), LDS_BYTES, stream, a); }
#else
    a.ph_lo = 0; a.ph_hi = N_PHASES;
    hipLaunchKernelGGL(fwd, dim3(grid), dim3(NWAVES * 64), LDS_BYTES, stream, a);
#endif
    const hipError_t le = hipPeekAtLastError();
    if (le != hipSuccess) fprintf(stderr, "kernel_launch: launch failed: %s\n", hipGetErrorName(le));
}
```

```cpp
#include <hip/hip_runtime.h>
#include <cstdio>
#include <cstdint>
#include <cmath>
#ifndef MK_PER_PHASE
#define MK_PER_PHASE 0
#endif
namespace pg8 {
#define PG8_LAS __attribute__((address_space(3)))
typedef unsigned short bf16_t;
typedef short bf16x8 __attribute__((ext_vector_type(8)));
typedef float f32x4 __attribute__((ext_vector_type(4)));
typedef unsigned u32x4 __attribute__((ext_vector_type(4)));
constexpr int BM = 256, BK = 64, HALF = 128, HTB = HALF * BK * 2  , STAGE_BYTES = 8 * HTB, NXCD = 8, WGM = 8;

__host__ __device__ __forceinline__ int lds_byte(int r, int c) { const int st = (r >> 4) * 2 + (c >> 5), rr = r & 15, cc = c & 31, ob = rr * 64 + cc * 2; return st * 1024 + (ob ^ (((ob >> 9) & 1) << 5)); }
__host__ __device__ __forceinline__ void stage_rc(int b, int& R, int& C) { const int st = b / 1024, sb = b % 1024, swz = sb ^ (((sb >> 9) & 1) << 5); R = (st >> 1) * 16 + swz / 64; C = (st & 1) * 32 + (swz % 64) / 2; }
__host__ __device__ __forceinline__ int perm32(int rho) { const int n = rho >> 4, i = rho & 15; return 8 * (i >> 2) + 4 * n + (i & 3); }

__host__ __device__ __forceinline__ size_t ablk_byte(int r, int c, int ld) { return ((size_t)(r >> 7) * (ld >> 6) + (c >> 6)) * HTB + lds_byte(r & 127, c & 63); }
__host__ __device__ __forceinline__ size_t bblk_byte(int n, int k, int ld) { const int nl = n & 127, x = nl & 31, rho = 16 * ((x >> 2) & 1) + 4 * (x >> 3) + (x & 3);
    return ((size_t)(n >> 7) * (ld >> 6) + (k >> 6)) * HTB + lds_byte((nl & ~31) + rho, k & 63); }
struct Unit { int pm, pn, kq; };
struct Gemm { const bf16_t* A; const bf16_t* Bt; int M, N, K, ld, ablk, bblk; };

struct StaticOrder {
    int nM, nN, nwg, G, c;
    __host__ __device__ void init(int M, int N, int G_, int c_) { nM = M / BM; nN = N / BM; nwg = nM * nN; G = G_; c = c_; }
    __host__ __device__ bool next(int i, Unit& u) const {
        const long L = (long)i * G + c; if (L >= nwg) return false;
        int wgid = (int)L; { const int q = nwg / NXCD, r = nwg % NXCD, xcd = wgid % NXCD, off = wgid / NXCD; wgid = (xcd < r ? xcd * (q + 1) : r * (q + 1) + (xcd - r) * q) + off; }
        const int nig = WGM * nN, gid = wgid / nig, fm = gid * WGM, gsz = (nM - fm) < WGM ? (nM - fm) : WGM;
        u.pm = fm + ((wgid % nig) % gsz); u.pn = (wgid % nig) / gsz; u.kq = 0; return true;
    }
    __device__ __forceinline__ void a_ready(const Unit&) const {}
    __device__ __forceinline__ void done(const Unit&) const {}
};

struct Order8 {
    int nN, nwg, G, c, q, rev = 0, wgm = WGM;
    __host__ __device__ void init(int M, int N, int G_, int c_) { nN = N / BM; nwg = (M / BM) * nN; G = G_; c = c_; q = nwg / NXCD; }
    __host__ __device__ bool next(int i, Unit& u) const {
        const int L0 = i * G + c; if (L0 >= nwg) return false; const int L = rev ? nwg - 1 - L0 : L0;
        const int wgid = (L % NXCD) * q + L / NXCD, nig = wgm * nN, gid = wgid / nig, w = wgid % nig;
        u.pm = gid * wgm + (w % wgm); u.pn = w / wgm; u.kq = 0; return true;
    }
    __device__ __forceinline__ void a_ready(const Unit&) const {}
    __device__ __forceinline__ void done(const Unit&) const {}
};

struct GateOrder {
    int r, nr, nM;
    __device__ __forceinline__ bool next(int i, Unit& u) const { const int idx = r + i * nr; if (idx >= nM) return false; u.pm = idx; u.pn = 24; u.kq = 0; return true; }
    __device__ __forceinline__ void a_ready(const Unit&) const {}
    __device__ __forceinline__ void done(const Unit&) const {}
};

struct SplitK4Order {
    int c;
    __device__ __forceinline__ bool next(int i, Unit& u) const { if (i > 0 || c >= 256) return false; const int t = c >> 2; u.kq = c & 3; u.pm = t & 7; u.pn = t >> 3; return true; }
    __device__ __forceinline__ void a_ready(const Unit&) const {}
    __device__ __forceinline__ void done(const Unit&) const {}
};

__device__ __forceinline__ unsigned cvt_pk_bf16(float lo, float hi) { unsigned r; asm volatile("v_cvt_pk_bf16_f32 %0, %1, %2" : "=v"(r) : "v"(lo), "v"(hi)); return r; }
typedef float f32x2 __attribute__((ext_vector_type(2)));

constexpr int E_DM = 2048, E_NMOD = 12288, E_ML = 32768;
typedef _Float16 h16_t; typedef _Float16 h16x8 __attribute__((ext_vector_type(8))); typedef float f32x8 __attribute__((ext_vector_type(8)));
__device__ __forceinline__ void epi_glds4(const float* src, PG8_LAS unsigned char* dst) { __builtin_amdgcn_global_load_lds((const unsigned*)src, (PG8_LAS unsigned*)dst, 4, 0, 0); }
__device__ __forceinline__ float epi_sum4(float v) {
    float a = v, b = v; asm volatile("s_nop 1\n\tv_permlane16_swap_b32 %0, %1" : "+v"(a), "+v"(b)); a += b; b = a; asm volatile("s_nop 1\n\tv_permlane32_swap_b32 %0, %1" : "+v"(a), "+v"(b)); return a + b; }
struct EpiRes {
    static constexpr bool PERM = true, AFTER_DRAIN = false, DUPOK = false;
    static constexpr int NST_LO = 8, NST_HI = 8; __device__ __forceinline__ bool nst_hi() const { return false; }
    h16_t* hl; const h16_t* hin; const float* mods; int goff; int dummy;
    bf16_t* un; float* ssacc; const float* gain_n; const float* sc_n;
    __device__ __forceinline__ void prefetch(const Unit& u, PG8_LAS unsigned char* xl, int par, int wid, int lane) const {
        PG8_LAS unsigned char* d = xl + par * 4096; const int bidx = u.pm >> 4, c = u.pn * BM + 64 * (wid & 3) + lane;
        if (wid < 4) { epi_glds4(mods + bidx * E_NMOD + goff + c, d + wid * 256); if (un) epi_glds4(sc_n + bidx * E_NMOD + c, d + 2048 + wid * 256); }
        else if (un) epi_glds4(gain_n + c, d + 1024 + (wid - 4) * 256);
    }
    __device__ __forceinline__ void operator()(const f32x4 (&acc)[2][2][4][2], const Unit& u, int wr, int wc, int fr, int fq, PG8_LAS unsigned char* xl, int par) const {
        { unsigned z_ = 0u; asm volatile("" : "+s"(z_)); const int l_ = (int)__builtin_amdgcn_mbcnt_hi(~0u, __builtin_amdgcn_mbcnt_lo(~0u, z_)); fr = l_ & 15; fq = l_ >> 4; }
        const int bidx = u.pm >> 4;
        h16_t* base = hl + (size_t)(dummy ? (u.pm & 63) : u.pm) * 256 * E_DM;
        const h16_t* rbase = (dummy ? (const h16_t*)hl : hin) + (size_t)(dummy ? (u.pm & 63) : u.pm) * 256 * E_DM;
        float* sbase = ssacc + (size_t)u.pm * 256; const unsigned ulo = (unsigned)lds_byte(fr, 8 * fq) + (unsigned)(wc & 1) * 1024u;
        int col0 = u.pn * BM + wc * 32 + 8 * fq; const int rl = wr * 64 + fr; asm volatile("" : "+v"(col0));
        const unsigned o0 = (unsigned)(rl * E_DM + col0);
        PG8_LAS unsigned char* xd = xl + par * 4096; const int cl = wc * 32 + 8 * fq;
        f32x4 gv[2][2], an[2][2];
#pragma unroll
        for (int bj = 0; bj < 2; ++bj)
#pragma unroll
            for (int n = 0; n < 2; ++n) { gv[bj][n] = *(const PG8_LAS f32x4*)(xd + (cl + bj * HALF + n * 4) * 4);
                if (un) { const f32x4 g = *(const PG8_LAS f32x4*)(xd + 1024 + (cl + bj * HALF + n * 4) * 4), sc = *(const PG8_LAS f32x4*)(xd + 2048 + (cl + bj * HALF + n * 4) * 4); an[bj][n] = g * (sc + 1.f); } }
#pragma unroll
        for (int ai = 0; ai < 2; ++ai) {
            unsigned og = o0 + (unsigned)(ai * HALF * E_DM); asm volatile("" : "+v"(og));
            u32x4 hw[4][2];
#pragma unroll
            for (int m = 0; m < 4; ++m)
#pragma unroll
                for (int bj = 0; bj < 2; ++bj) hw[m][bj] = *(const u32x4*)(rbase + (og + (unsigned)(m * 16 * E_DM + bj * HALF)));
#pragma unroll
            for (int m = 0; m < 4; ++m) { float ss = 0.f;
#pragma unroll
                for (int bj = 0; bj < 2; ++bj) { const unsigned oo = og + (unsigned)(m * 16 * E_DM + bj * HALF);
                    const f32x8 hf = __builtin_convertvector(__builtin_bit_cast(h16x8, hw[m][bj]), f32x8);
                    const f32x4 oa = __builtin_shufflevector(hf, hf, 0, 1, 2, 3) + gv[bj][0] * acc[ai][bj][m][0], ob = __builtin_shufflevector(hf, hf, 4, 5, 6, 7) + gv[bj][1] * acc[ai][bj][m][1];
                    *(h16x8*)(base + oo) = __builtin_convertvector(__builtin_shufflevector(oa, ob, 0, 1, 2, 3, 4, 5, 6, 7), h16x8);
                    if (un) { ss += ((oa[0] * oa[0] + oa[1] * oa[1]) + (oa[2] * oa[2] + oa[3] * oa[3])) + ((ob[0] * ob[0] + ob[1] * ob[1]) + (ob[2] * ob[2] + ob[3] * ob[3]));
                        const f32x4 qa = oa * an[bj][0], qb = ob * an[bj][1];
                        u32x4 w; w.x = cvt_pk_bf16(qa[0], qa[1]); w.y = cvt_pk_bf16(qa[2], qa[3]); w.z = cvt_pk_bf16(qb[0], qb[1]); w.w = cvt_pk_bf16(qb[2], qb[3]); *(u32x4*)((char*)un + (((size_t)(u.pm * 2 + ai) * (E_DM >> 6) + (u.pn * 4 + bj * 2 + (wc >> 1))) * HTB + (unsigned)((wr * 4 + m) * 2) * 1024u + ulo)) = w; } }
                if (un) { ss = epi_sum4(ss); if (fq == 0) __builtin_amdgcn_global_atomic_fadd_f32((__attribute__((address_space(1))) float*)(sbase + (rl + ai * HALF + m * 16)), ss);     } }
                asm volatile("" ::: "memory"); }
    }
};
struct NormIn {
    const float* ssl; const float* ssc; const float* bv; int N;
    __device__ __forceinline__ float rstd(const Unit& u, int rloc) const { const float ss = u.pm >= 128 ? ssc[(u.pm - 128) * 256 + rloc] : ssl[u.pm * 256 + rloc]; return 1.f / sqrtf(ss * (1.f / E_DM) + 1e-6f); }
    __device__ __forceinline__ const float* bias(const Unit& u) const { return bv + (size_t)(u.pm >= 128 ? 8 : (u.pm >> 4)) * N; }
    __device__ __forceinline__ void prefetch(const Unit& u, PG8_LAS unsigned char* xl, int par, int wid, int lane) const {
        PG8_LAS unsigned char* d = xl + par * 4096;
        if (wid < 4) epi_glds4((u.pm >= 128 ? ssc + (u.pm - 128) * 256 : ssl + u.pm * 256) + 64 * wid + lane, d + wid * 256);
        else epi_glds4(bias(u) + u.pn * BM + 64 * (wid - 4) + lane, d + 1024 + (wid - 4) * 256);
    }
    __device__ __forceinline__ float rstd_l(PG8_LAS unsigned char* d, int rloc) const { return __builtin_amdgcn_rsqf(*(const PG8_LAS float*)(d + rloc * 4) * (1.f / E_DM) + 1e-6f); }
};
struct EpiPart {
    static constexpr bool PERM = true, AFTER_DRAIN = false, DUPOK = false;
    static constexpr int NST_LO = 0, NST_HI = 0; __device__ __forceinline__ bool nst_hi() const { return false; }
    h16_t* P;
    __device__ __forceinline__ void prefetch(const Unit&, PG8_LAS unsigned char*, int, int, int) const {}
    __device__ __forceinline__ void operator()(const f32x4 (&acc)[2][2][4][2], const Unit& u, int wr, int wc, int fr, int fq, PG8_LAS unsigned char* xl, int par) const {
        { unsigned z_ = 0u; asm volatile("" : "+s"(z_)); const int l_ = (int)__builtin_amdgcn_mbcnt_hi(~0u, __builtin_amdgcn_mbcnt_lo(~0u, z_)); fr = l_ & 15; fq = l_ >> 4; }
        h16_t* base = P + ((size_t)u.kq * 2048 + (size_t)u.pm * BM) * E_DM; const int col0 = u.pn * BM + wc * 32 + 8 * fq, rl = wr * 64 + fr;
#pragma unroll
        for (int ai = 0; ai < 2; ++ai)
#pragma unroll
            for (int m = 0; m < 4; ++m) { h16_t* rowp = base + (size_t)(rl + ai * HALF + m * 16) * E_DM + col0;
#pragma unroll
                for (int bj = 0; bj < 2; ++bj) *(h16x8*)(rowp + bj * HALF) = __builtin_convertvector(__builtin_shufflevector(acc[ai][bj][m][0], acc[ai][bj][m][1], 0, 1, 2, 3, 4, 5, 6, 7), h16x8); }
    }
};
struct EpiSqRelu {
    static constexpr bool PERM = true, AFTER_DRAIN = false, DUPOK = true;
    static constexpr int NST_LO = 16, NST_HI = 16; __device__ __forceinline__ bool nst_hi() const { return false; }
    bf16_t* O; int ldc; NormIn ni;
    __device__ __forceinline__ void prefetch(const Unit& u, PG8_LAS unsigned char* xl, int par, int wid, int lane) const { ni.prefetch(u, xl, par, wid, lane); }
    __device__ __forceinline__ void operator()(const f32x4 (&acc)[2][2][4][2], const Unit& u, int wr, int wc, int fr, int fq, PG8_LAS unsigned char* xl, int par) const {
        { unsigned z_ = 0u; asm volatile("" : "+s"(z_)); const int l_ = (int)__builtin_amdgcn_mbcnt_hi(~0u, __builtin_amdgcn_mbcnt_lo(~0u, z_)); fr = l_ & 15; fq = l_ >> 4; }
        PG8_LAS unsigned char* xd = xl + par * 4096; const int cl = wc * 32 + 8 * fq;
        char* ob = (char*)O; const unsigned lo = (unsigned)lds_byte(fr, 8 * fq) + (unsigned)(wc & 1) * 1024u;
        f32x4 bv[2][2];
#pragma unroll
        for (int bj = 0; bj < 2; ++bj) { bv[bj][0] = *(const PG8_LAS f32x4*)(xd + 1024 + (cl + bj * HALF) * 4); bv[bj][1] = *(const PG8_LAS f32x4*)(xd + 1024 + (cl + bj * HALF + 4) * 4); }
#pragma unroll
        for (int ai = 0; ai < 2; ++ai)
#pragma unroll
            for (int m = 0; m < 4; ++m) { const float rs = ni.rstd_l(xd, wr * 64 + fr + ai * HALF + m * 16);
#pragma unroll
                for (int bj = 0; bj < 2; ++bj) { f32x4 v0 = acc[ai][bj][m][0] * rs + bv[bj][0], v1 = acc[ai][bj][m][1] * rs + bv[bj][1];
#pragma unroll
                    for (int j = 0; j < 4; ++j) { const float a = fmaxf(v0[j], 0.f), b = fmaxf(v1[j], 0.f); v0[j] = a * a; v1[j] = b * b; }
                    u32x4 w; w.x = cvt_pk_bf16(v0[0], v0[1]); w.y = cvt_pk_bf16(v0[2], v0[3]); w.z = cvt_pk_bf16(v1[0], v1[1]); w.w = cvt_pk_bf16(v1[2], v1[3]);
#ifdef NT_HID
                    __builtin_nontemporal_store(w, (u32x4*)(ob + (((size_t)(u.pm * 2 + ai) * (ldc >> 6) + (u.pn * 4 + bj * 2 + (wc >> 1))) * HTB + (unsigned)((wr * 4 + m) * 2) * 1024u + lo)));
#else
                    *(u32x4*)(ob + (((size_t)(u.pm * 2 + ai) * (ldc >> 6) + (u.pn * 4 + bj * 2 + (wc >> 1))) * HTB + (unsigned)((wr * 4 + m) * 2) * 1024u + lo)) = w;
#endif
#ifdef DUP_ST
                    asm volatile("" ::: "memory"); *(u32x4*)(ob + (((size_t)(u.pm * 2 + ai) * (ldc >> 6) + (u.pn * 4 + bj * 2 + (wc >> 1))) * HTB + (unsigned)((wr * 4 + m) * 2) * 1024u + lo)) = w;
#endif
                    } }
    }
};
struct EpiQKV {
    static constexpr bool PERM = true, AFTER_DRAIN = false, DUPOK = false;
    static constexpr int NST_LO = 0, NST_HI = 0; __device__ __forceinline__ bool nst_hi() const { return false; }
    bf16_t* O; int ldc; int qtiles; float qscale; NormIn ni;
    __device__ __forceinline__ void prefetch(const Unit& u, PG8_LAS unsigned char* xl, int par, int wid, int lane) const { ni.prefetch(u, xl, par, wid, lane); }
    __device__ __forceinline__ void operator()(const f32x4 (&acc)[2][2][4][2], const Unit& u, int wr, int wc, int fr, int fq, PG8_LAS unsigned char* xl, int par) const {
        { unsigned z_ = 0u; asm volatile("" : "+s"(z_)); const int l_ = (int)__builtin_amdgcn_mbcnt_hi(~0u, __builtin_amdgcn_mbcnt_lo(~0u, z_)); fr = l_ & 15; fq = l_ >> 4; }
        int col0 = u.pn * BM + wc * 32 + 8 * fq; asm volatile("" : "+v"(col0)); const float sc = u.pn < qtiles ? qscale : 1.f; PG8_LAS unsigned char* xd = xl + par * 4096; const int cl = wc * 32 + 8 * fq; bf16_t* tb = O + (size_t)u.pm * BM * ldc; const unsigned o0 = (unsigned)((wr * 64 + fr) * ldc + col0);
        f32x4 bv[2][2];
#pragma unroll
        for (int bj = 0; bj < 2; ++bj) { bv[bj][0] = *(const PG8_LAS f32x4*)(xd + 1024 + (cl + bj * HALF) * 4); bv[bj][1] = *(const PG8_LAS f32x4*)(xd + 1024 + (cl + bj * HALF + 4) * 4); }
#pragma unroll
        for (int ai = 0; ai < 2; ++ai)
#pragma unroll
            for (int m = 0; m < 4; ++m) { unsigned og = o0 + (unsigned)((ai * HALF + m * 16) * ldc); asm volatile("" : "+v"(og)); bf16_t* rowp = tb + og; const float rs = ni.rstd_l(xd, wr * 64 + fr + ai * HALF + m * 16);
#pragma unroll
                for (int bj = 0; bj < 2; ++bj) { const f32x4 v0 = (acc[ai][bj][m][0] * rs + bv[bj][0]) * sc, v1 = (acc[ai][bj][m][1] * rs + bv[bj][1]) * sc;
                    u32x4 w; w.x = cvt_pk_bf16(v0[0], v0[1]); w.y = cvt_pk_bf16(v0[2], v0[3]); w.z = cvt_pk_bf16(v1[0], v1[1]); w.w = cvt_pk_bf16(v1[2], v1[3]);
                    *(u32x4*)(rowp + bj * HALF) = w; } }
    }
};
struct EpiMl {
    static constexpr bool PERM = true, AFTER_DRAIN = false, DUPOK = false;
    static constexpr int NST_LO = 0, NST_HI = 0; __device__ __forceinline__ bool nst_hi() const { return false; }
    bf16_t *Q, *K, *V, *OG; float* G; const float* bgate; const PG8_LAS unsigned char* ropel; NormIn ni;
    __device__ __forceinline__ void prefetch(const Unit& u, PG8_LAS unsigned char* xl, int par, int wid, int lane) const { ni.prefetch(u, xl, par, wid, lane); }
    __device__ __forceinline__ void operator()(const f32x4 (&accr)[2][2][4][2], const Unit& u, int wr, int wc, int fr, int fq, PG8_LAS unsigned char* xl, int par) const {
        { unsigned z_ = 0u; asm volatile("" : "+s"(z_)); const int l_ = (int)__builtin_amdgcn_mbcnt_hi(~0u, __builtin_amdgcn_mbcnt_lo(~0u, z_)); fr = l_ & 15; fq = l_ >> 4; }
        const int row0 = u.pm * BM + wr * 64 + fr;
        f32x4 bv[2][2]; float rs8[2][4];
        { PG8_LAS unsigned char* xd = xl + par * 4096; const int cl = wc * 32 + 8 * fq;
#pragma unroll
          for (int bj = 0; bj < 2; ++bj) { bv[bj][0] = *(const PG8_LAS f32x4*)(xd + 1024 + (cl + bj * HALF) * 4); bv[bj][1] = *(const PG8_LAS f32x4*)(xd + 1024 + (cl + bj * HALF + 4) * 4); }
#pragma unroll
          for (int ai = 0; ai < 2; ++ai)
#pragma unroll
              for (int m = 0; m < 4; ++m) rs8[ai][m] = ni.rstd_l(xd, wr * 64 + fr + ai * HALF + m * 16); }
#define acc_at(ai, bj, m, n) (accr[ai][bj][m][n] * rs8[ai][m] + bv[bj][n])
        if (u.pn < 8) {
            bf16_t* dst = u.pn < 4 ? Q : K; const float ksc = u.pn < 4 ? 1.f : 0.08838834764831845f; const bool lat = u.pm < 128;
            const int col0 = (u.pn & 3) * BM + wc * 32 + 8 * fq, half = wc >> 1, j0 = 16 * (wc & 1) + 4 * fq;
#pragma unroll
            for (int ai = 0; ai < 2; ++ai)
#pragma unroll
                for (int m = 0; m < 4; ++m) {
                    const int pos = half ? (16 * m + fr) : ((4 * u.pm + 2 * ai + wr) & 63);
                    const PG8_LAS f32x4* rp = (const PG8_LAS f32x4*)(ropel + pos * 272 + j0 * 8); const f32x4 cs0 = rp[0], cs1 = rp[1];
                    unsigned og = (unsigned)((wr * 64 + fr + ai * HALF + m * 16) * 1024 + col0); asm volatile("" : "+v"(og)); bf16_t* rowp = dst + (size_t)u.pm * BM * 1024 + og;
#pragma unroll
                    for (int bj = 0; bj < 2; ++bj) { f32x4 v0 = acc_at(ai, bj, m, 0), v1 = acc_at(ai, bj, m, 1);
                        if (lat) { f32x4 r0, r1;
                            r0[0] = v0[0] * cs0[0] - v0[1] * cs0[1]; r0[1] = v0[0] * cs0[1] + v0[1] * cs0[0];
                            r0[2] = v0[2] * cs0[2] - v0[3] * cs0[3]; r0[3] = v0[2] * cs0[3] + v0[3] * cs0[2];
                            r1[0] = v1[0] * cs1[0] - v1[1] * cs1[1]; r1[1] = v1[0] * cs1[1] + v1[1] * cs1[0];
                            r1[2] = v1[2] * cs1[2] - v1[3] * cs1[3]; r1[3] = v1[2] * cs1[3] + v1[3] * cs1[2];
                            v0 = r0; v1 = r1; }
                        v0 = v0 * ksc; v1 = v1 * ksc;
                        u32x4 w; w.x = cvt_pk_bf16(v0[0], v0[1]); w.y = cvt_pk_bf16(v0[2], v0[3]); w.z = cvt_pk_bf16(v1[0], v1[1]); w.w = cvt_pk_bf16(v1[2], v1[3]);
                        *(u32x4*)(rowp + bj * HALF) = w; } }
        } else if (u.pn < 24) {
            const bool isog = u.pn >= 16; bf16_t* dst = isog ? OG : V; const int col0 = ((u.pn - 8) & 7) * BM + wc * 32 + 8 * fq;
#pragma unroll
            for (int ai = 0; ai < 2; ++ai)
#pragma unroll
                for (int m = 0; m < 4; ++m) { unsigned og = (unsigned)((wr * 64 + fr + ai * HALF + m * 16) * 2048 + col0); asm volatile("" : "+v"(og)); bf16_t* rowp = dst + (size_t)u.pm * BM * 2048 + og;
#pragma unroll
                    for (int bj = 0; bj < 2; ++bj) { f32x4 v0 = acc_at(ai, bj, m, 0), v1 = acc_at(ai, bj, m, 1);
                        if (isog) {
#pragma unroll
                            for (int j = 0; j < 4; ++j) { v0[j] = __builtin_amdgcn_rcpf(1.f + __expf(-v0[j])); v1[j] = __builtin_amdgcn_rcpf(1.f + __expf(-v1[j])); } }
                        u32x4 w; w.x = cvt_pk_bf16(v0[0], v0[1]); w.y = cvt_pk_bf16(v0[2], v0[3]); w.z = cvt_pk_bf16(v1[0], v1[1]); w.w = cvt_pk_bf16(v1[2], v1[3]);
                        *(u32x4*)(rowp + bj * HALF) = w; } }
        } else if (wc == 0) {
            const f32x4 b0 = *(const f32x4*)(bgate + 8 * fq), b1 = *(const f32x4*)(bgate + 8 * fq + 4); const bool isf = (fq & 1) != 0;
#pragma unroll
            for (int ai = 0; ai < 2; ++ai)
#pragma unroll
                for (int m = 0; m < 4; ++m) { f32x4 v0 = acc_at(ai, 0, m, 0) + b0, v1 = acc_at(ai, 0, m, 1) + b1;
#pragma unroll
                    for (int j = 0; j < 4; ++j) {
                        float a = v0[j] * (1.f / 15.f), b = v1[j] * (1.f / 15.f);
                        a = 15.f * (1.f - 2.f * __builtin_amdgcn_rcpf(__expf(2.f * a) + 1.f)); b = 15.f * (1.f - 2.f * __builtin_amdgcn_rcpf(__expf(2.f * b) + 1.f));
                        if (isf) { a = fminf(a, 0.f) - log1pf(__expf(-fabsf(a))); b = fminf(b, 0.f) - log1pf(__expf(-fabsf(b))); }
                        v0[j] = a; v1[j] = b; }
                    float* gp = G + (size_t)(row0 + ai * HALF + m * 16) * 32 + 8 * fq; *(f32x4*)gp = v0; *(f32x4*)(gp + 4) = v1; }
        }
    }
#undef acc_at
};
template <int N> __device__ __forceinline__ void pg8_wait_vm() { asm volatile("s_waitcnt vmcnt(%0)" :: "n"(N) : "memory"); }
template <class Epi, class Sched, bool ALIGN_EPI = false, bool SP2 = false, bool NARROW = false>
__device__ __forceinline__ void gemm_phase(PG8_LAS unsigned char* lds, const Gemm g, const Sched& S, const Epi& E, const int tid_in) {
    const int tid = tid_in, wid = __builtin_amdgcn_readfirstlane(tid >> 6), lane = tid & 63, wr = wid >> 2, wc = wid & 3, fr = lane & 15, fq = lane >> 4;
    const int K = g.ld, nt = g.K / BK;
    unsigned voffA[2], voffB[2];
#pragma unroll
    for (int i = 0; i < 2; ++i) { int R, C; stage_rc(tid * 16 + i * 8192, R, C); const int Rb = Epi::PERM ? ((R & ~31) + perm32(R & 31)) : R;
        voffA[i] = g.ablk ? (unsigned)(tid * 16 + i * 8192) : (unsigned)(R * K + C) * 2u; voffB[i] = g.bblk ? (unsigned)(tid * 16 + i * 8192) : (unsigned)(Rb * K + C) * 2u; }
    const size_t kstep = (size_t)(BK * 2);
    const size_t kstepA = g.ablk ? (size_t)HTB : kstep;
    const size_t kqA = g.ablk ? (size_t)g.K * 256 : (size_t)g.K * 2;
    const size_t kstepB = g.bblk ? (size_t)HTB : kstep, kqB = g.bblk ? (size_t)g.K * 256 : (size_t)g.K * 2;
    const size_t hstep = (size_t)HALF * K * 2;
    const size_t tstep = 2 * hstep;
    const unsigned ldsw = (unsigned)wid * 1024u;
    const int aoff = lds_byte(wr * 64 + fr, fq * 8), boff = lds_byte(wc * 32 + fr, fq * 8);
#define PG8_SA(b, h) (((b) * 2 + (h)) * HTB)
#define PG8_SB(b, h) ((4 + (b) * 2 + (h)) * HTB)
#define PG8_STAGE(bufoff, gbase, voff) do { _Pragma("unroll") for (int _i = 0; _i < 2; ++_i) \
        __builtin_amdgcn_global_load_lds((const unsigned*)((const char*)(gbase) + (voff)[_i]), (PG8_LAS unsigned*)(lds + (bufoff) + ldsw + _i * 8192), 16, 0, 0); } while (0)
#define PG8_LDA(dst, b, h) do { if (!NARROW || wc == 0) _Pragma("unroll") for (int m = 0; m < 4; ++m) _Pragma("unroll") for (int k = 0; k < 2; ++k) dst[m][k] = *(const PG8_LAS bf16x8*)(lds + PG8_SA(b, h) + aoff + m * 2048 + k * 1024); } while (0)
#define PG8_LDB(dst, b, h) do { if (!NARROW || ((h) == 0 && wc == 0)) _Pragma("unroll") for (int n = 0; n < 2; ++n) _Pragma("unroll") for (int k = 0; k < 2; ++k) dst[n][k] = *(const PG8_LAS bf16x8*)(lds + PG8_SB(b, h) + boff + n * 2048 + k * 1024); } while (0)
#define PG8_MMA(ai, bj, At, Bt) do { if (NARROW && ((bj) != 0 || wc != 0)) break; __builtin_amdgcn_s_setprio(1); _Pragma("unroll") for (int m = 0; m < 4; ++m) _Pragma("unroll") for (int n = 0; n < 2; ++n) _Pragma("unroll") for (int k = 0; k < 2; ++k) \
        acc[ai][bj][m][n] = __builtin_amdgcn_mfma_f32_16x16x32_bf16(Bt[n][k], At[m][k], acc[ai][bj][m][n], 0, 0, 0); __builtin_amdgcn_s_setprio(0); } while (0)
#define PG8_WAIT_V(n) asm volatile("s_waitcnt vmcnt(" #n ")" ::: "memory")
#define PG8_WAIT_L(n) asm volatile("s_waitcnt lgkmcnt(" #n ")" ::: "memory")
#define PG8_BAR __builtin_amdgcn_s_barrier()
#define PG8_SCHED __builtin_amdgcn_sched_barrier(0)
    Unit cur, nxt; int ui = 0;
    if (!S.next(0, cur)) return;
    f32x4 acc[2][2][4][2];
#pragma unroll
    for (int a = 0; a < 2; ++a)
#pragma unroll
        for (int b = 0; b < 2; ++b)
#pragma unroll
            for (int m = 0; m < 4; ++m)
#pragma unroll
                for (int n = 0; n < 2; ++n) acc[a][b][m][n] = (f32x4){0.f, 0.f, 0.f, 0.f};
    bf16x8 At[4][2], B0[2][2], B1[2][2];
    const char* cA = (const char*)g.A + (size_t)cur.pm * tstep + (size_t)cur.kq * kqA; const char* cB = (const char*)g.Bt + (size_t)cur.pn * tstep + (size_t)cur.kq * kqB;
    PG8_LAS unsigned char* const xl = lds + STAGE_BYTES + 1024;
    S.a_ready(cur); E.prefetch(cur, xl, 0, wid, lane);
    if constexpr (SP2) {
        PG8_STAGE(PG8_SB(0, 0), cB, voffB); PG8_STAGE(PG8_SB(0, 1), cB + hstep, voffB); PG8_STAGE(PG8_SA(0, 0), cA, voffA); PG8_STAGE(PG8_SA(0, 1), cA + hstep, voffA);
        if (wr == 1) PG8_BAR;
        PG8_WAIT_V(2); PG8_BAR;
        PG8_STAGE(PG8_SB(1, 0), cB + kstepB, voffB); PG8_STAGE(PG8_SA(1, 0), cA + kstepA, voffA); PG8_STAGE(PG8_SB(1, 1), cB + hstep + kstepB, voffB);
        PG8_WAIT_V(6); PG8_BAR;
    } else {
        PG8_STAGE(PG8_SB(0, 0), cB, voffB); PG8_STAGE(PG8_SA(0, 0), cA, voffA); PG8_STAGE(PG8_SB(0, 1), cB + hstep, voffB); PG8_STAGE(PG8_SA(0, 1), cA + hstep, voffA);
        if (wr == 1) PG8_BAR;
        PG8_WAIT_V(4); PG8_BAR;
        PG8_STAGE(PG8_SB(1, 0), cB + kstepB, voffB); PG8_STAGE(PG8_SA(1, 0), cA + kstepA, voffA); PG8_STAGE(PG8_SB(1, 1), cB + hstep + kstepB, voffB);
        PG8_WAIT_V(6); PG8_BAR;
    }
    for (;;) {
        const bool has_next = S.next(ui + 1, nxt);
        const char* nA = has_next ? (const char*)g.A + (size_t)nxt.pm * tstep + (size_t)nxt.kq * kqA : cA; const char* nB = has_next ? (const char*)g.Bt + (size_t)nxt.pn * tstep + (size_t)nxt.kq * kqB : cB;
        for (int t = 0; t < nt; t += 2) {
            const bool last = (t == nt - 2);
            const char* a1 = cA + (size_t)(t + 1) * kstepA;
            const char* a2 = last ? nA : cA + (size_t)(t + 2) * kstepA; const char* b2 = last ? nB : cB + (size_t)(t + 2) * kstepB;
            const char* a3 = a2 + kstepA; const char* b3 = b2 + kstepB;
            if (last && has_next) { S.a_ready(nxt); E.prefetch(nxt, xl, (ui + 1) & 1, wid, lane); }
            if constexpr (SP2) {
#define PG8_SP12(WAITV) do { \
            PG8_LDB(B0, 0, 0); PG8_LDB(B1, 0, 1); PG8_SCHED; PG8_LDA(At, 0, 0); PG8_STAGE(PG8_SA(1, 1), a1 + hstep, voffA); \
            WAITV; PG8_WAIT_L(0); PG8_BAR; PG8_MMA(0, 0, At, B0); PG8_MMA(0, 1, At, B1); PG8_BAR; PG8_SCHED; \
            PG8_LDA(At, 0, 1); PG8_STAGE(PG8_SB(0, 0), b2, voffB); PG8_STAGE(PG8_SB(0, 1), b2 + hstep, voffB); PG8_STAGE(PG8_SA(0, 0), a2, voffA); \
            WAITV; PG8_WAIT_L(0); PG8_BAR; PG8_MMA(1, 0, At, B0); PG8_MMA(1, 1, At, B1); PG8_BAR; PG8_SCHED; } while (0)
            if constexpr (Epi::NST_LO > 0) PG8_SP12(do { if (t == 0 && ui > 0) pg8_wait_vm<8 + Epi::NST_LO>(); else PG8_WAIT_V(8); } while (0)); else PG8_SP12(PG8_WAIT_V(8));
            PG8_LDB(B0, 1, 0); PG8_LDB(B1, 1, 1); PG8_SCHED; PG8_LDA(At, 1, 0); PG8_STAGE(PG8_SA(0, 1), a2 + hstep, voffA);
            PG8_WAIT_V(8); PG8_WAIT_L(0); PG8_BAR; PG8_MMA(0, 0, At, B0); PG8_MMA(0, 1, At, B1); PG8_BAR; PG8_SCHED;
            PG8_LDA(At, 1, 1); PG8_STAGE(PG8_SB(1, 0), b3, voffB); PG8_STAGE(PG8_SB(1, 1), b3 + hstep, voffB); PG8_STAGE(PG8_SA(1, 0), a3, voffA);
            PG8_WAIT_V(8); PG8_WAIT_L(0); PG8_BAR; PG8_MMA(1, 0, At, B0); PG8_MMA(1, 1, At, B1); PG8_BAR; PG8_SCHED;
            } else {
            PG8_LDB(B0, 0, 0); PG8_SCHED; PG8_LDA(At, 0, 0); PG8_STAGE(PG8_SA(1, 1), a1 + hstep, voffA);
            PG8_WAIT_L(8); PG8_BAR; PG8_WAIT_L(0); PG8_MMA(0, 0, At, B0); PG8_BAR; PG8_SCHED;
            PG8_LDB(B1, 0, 1); PG8_STAGE(PG8_SB(0, 0), b2, voffB);
            PG8_BAR; PG8_WAIT_L(0); PG8_MMA(0, 1, At, B1); PG8_BAR;
            PG8_LDA(At, 0, 1); PG8_STAGE(PG8_SA(0, 0), a2, voffA);
            PG8_BAR; PG8_WAIT_L(0); PG8_MMA(1, 0, At, B0); PG8_BAR; PG8_SCHED;
            PG8_STAGE(PG8_SB(0, 1), b2 + hstep, voffB);
            PG8_WAIT_V(6); PG8_BAR; PG8_MMA(1, 1, At, B1); PG8_BAR;
            PG8_LDB(B0, 1, 0); PG8_SCHED; PG8_LDA(At, 1, 0); PG8_STAGE(PG8_SA(0, 1), a2 + hstep, voffA);
            PG8_WAIT_L(8); PG8_BAR; PG8_WAIT_L(0); PG8_MMA(0, 0, At, B0); PG8_BAR; PG8_SCHED;
            PG8_LDB(B1, 1, 1); PG8_STAGE(PG8_SB(1, 0), b3, voffB);
            PG8_BAR; PG8_WAIT_L(0); PG8_MMA(0, 1, At, B1); PG8_BAR;
            PG8_LDA(At, 1, 1); PG8_STAGE(PG8_SA(1, 0), a3, voffA);
            PG8_BAR; PG8_WAIT_L(0); PG8_MMA(1, 0, At, B0); PG8_BAR; PG8_SCHED;
            PG8_STAGE(PG8_SB(1, 1), b3 + hstep, voffB);
            PG8_WAIT_V(6); PG8_BAR; PG8_MMA(1, 1, At, B1); PG8_BAR;
            }
        }
        if constexpr (ALIGN_EPI) { if (wr == 0) PG8_BAR; }
        if constexpr (!Epi::AFTER_DRAIN) { E(acc, cur, wr, wc, fr, fq, xl, ui & 1);
#ifdef DUP_EPI
            if constexpr (Epi::DUPOK) { asm volatile("" ::: "memory"); E(acc, cur, wr, wc, fr, fq, xl, ui & 1); }
#endif
#ifdef DRAIN_EPI
            asm volatile("s_waitcnt vmcnt(0)" ::: "memory");
#endif
            S.done(cur); }
        if (!has_next) break;
#pragma unroll
        for (int a = 0; a < 2; ++a)
#pragma unroll
            for (int b = 0; b < 2; ++b)
#pragma unroll
                for (int m = 0; m < 4; ++m)
#pragma unroll
                    for (int n = 0; n < 2; ++n) acc[a][b][m][n] = (f32x4){0.f, 0.f, 0.f, 0.f};
        cur = nxt; cA = nA; cB = nB; ++ui;
        if constexpr (ALIGN_EPI) { if (wr == 1) PG8_BAR; }
    }
    PG8_WAIT_V(0);
    if constexpr (!ALIGN_EPI) { if (wr == 0) PG8_BAR; }
    PG8_BAR;
    if constexpr (Epi::AFTER_DRAIN) { E.fused(acc, cur, wr, wc, fr, fq, lds, wid, lane); S.done(cur); }
#undef PG8_SA
#undef PG8_SB
#undef PG8_STAGE
#undef PG8_LDA
#undef PG8_LDB
#undef PG8_MMA
#undef PG8_WAIT_V
#undef PG8_WAIT_L
#undef PG8_BAR
#undef PG8_SCHED
}
}

constexpr int DM = 2048, NB = 8, SEQ = 4096, CTXL = 256, DEPTH = 4, DFF = 8192, NMOD = 6 * DM;
constexpr int ML = NB * SEQ, MC = NB * CTXL, MT = ML + MC;
constexpr int ML_NSRC = 6176, ML_NPAD = 6400;
constexpr int NWAVES = 8;
constexpr float RMS_EPS = 1e-6f, LOG2E = 1.4426950408889634f;
constexpr size_t MiB = 1u << 20;
constexpr size_t WS_CTL = 0, CTL_ZERO_BYTES = 1 * MiB;
constexpr size_t WS_MODS = 1 * MiB;
constexpr size_t WS_ROPE = 3 * MiB;
constexpr size_t WS_PART = 4 * MiB;
constexpr size_t WS_HC = 60 * MiB;
constexpr size_t WS_WML_IN = 76 * MiB, WS_WML_OUT = 126 * MiB, WS_WNA_QKV = 142 * MiB, WS_WNA_OUT = 190 * MiB, WS_W1 = 206 * MiB, WS_W2 = 334 * MiB;
constexpr size_t WS_U = 462 * MiB;
constexpr size_t WS_P = 598 * MiB;
constexpr size_t WS_MQ = WS_P, WS_MK = WS_P + 68 * MiB, WS_MV = WS_P + 136 * MiB, WS_MOG = WS_P + 272 * MiB, WS_MG = WS_P + 408 * MiB, WS_HF = WS_P + 413 * MiB, WS_HB = WS_P + 549 * MiB;
constexpr size_t WS_QKV = WS_P;
constexpr size_t WS_HID = WS_P;
constexpr size_t WS_END = WS_P + 685 * MiB;
constexpr size_t WS_PC = WS_END + 30 * MiB;
constexpr size_t WS_U2 = WS_PC + 64 * MiB;
constexpr size_t WS_H16 = WS_U2;
constexpr size_t WS_TOTAL = WS_U2 + 136 * MiB;
constexpr size_t WS_BVIN = WS_PART, WS_BVM1 = WS_PART + 1 * MiB;
constexpr size_t CTL_SSL_A = 512 * 1024, CTL_SSL_B = 640 * 1024, CTL_SSC_A = 768 * 1024, CTL_SSC_B = 776 * 1024;
static_assert(WS_HID + (size_t)MT * DFF * 2 <= WS_END && WS_QKV + (size_t)MT * 6144 * 2 <= WS_END && WS_MG + (size_t)MT * 32 * 4 <= WS_HF && WS_HB + (size_t)MT * DM * 2 <= WS_END, "d_ws map");
constexpr int CW_TMO = 0, CW_BAR = 4096;
constexpr int RING_BYTES = 131072, LDSCTL_OFF = RING_BYTES, MISC_OFF = LDSCTL_OFF + 320, LDS_BYTES = 163840;
constexpr int ROPE_LDS_OFF = LDSCTL_OFF + 1024 + 8192, ROPE_LDS_PITCH = 272;

#define GAS __attribute__((address_space(1)))
#define LAS __attribute__((address_space(3)))
typedef unsigned short bf16;
typedef unsigned v4u __attribute__((ext_vector_type(4)));
typedef float f32x4 __attribute__((ext_vector_type(4)));
typedef short bf16x8 __attribute__((ext_vector_type(8)));
typedef _Float16 h16;
typedef _Float16 h16x4 __attribute__((ext_vector_type(4)));
typedef GAS unsigned gu32;
typedef GAS unsigned long long gu64;
#define RLX_AGENT __ATOMIC_RELAXED, __HIP_MEMORY_SCOPE_AGENT
#define LDS_WAIT() asm volatile("s_waitcnt lgkmcnt(0)" ::: "memory")
#define VM_WAIT() asm volatile("s_waitcnt vmcnt(0)" ::: "memory")
__device__ __forceinline__ unsigned long long rt() { return __builtin_amdgcn_s_memrealtime(); }
__device__ __forceinline__ unsigned f2bf(float f) { unsigned u = __builtin_bit_cast(unsigned, f); return (u + 0x7fffu + ((u >> 16) & 1u)) >> 16; }
__device__ __forceinline__ unsigned pk2(float lo, float hi) { return f2bf(lo) | (f2bf(hi) << 16); }

#define XB_TMO      128
#define XB_XCNT(j)  (256  + 64 * (j))
#define XB_XSUB(j)  (1280 + 64 * (j))
#define XB_XGEN(j)  (2304 + 64 * (j))
#define XB_TOP      3328
#define XB_TOPGEN   3392
#define XCD_BAR_WORDS 3456
#define XB_SPIN_CAP (1u << 18)

__device__ __forceinline__ unsigned xb_ld(unsigned* p)              { return __hip_atomic_load(p, __ATOMIC_RELAXED, __HIP_MEMORY_SCOPE_AGENT); }
__device__ __forceinline__ unsigned xb_add(unsigned* p, unsigned v) { return __hip_atomic_fetch_add(p, v, __ATOMIC_RELAXED, __HIP_MEMORY_SCOPE_AGENT); }
__device__ __forceinline__ unsigned xb_xcc_id() { return (unsigned)__builtin_amdgcn_s_getreg((3 << 11) | 20) & 0xFu; }
#define XB_SPIN(cond, bar) do { unsigned _sp = 0; while (cond) { __builtin_amdgcn_s_sleep(6);     \
    if ((++_sp & 255u) == 0u) { if (xb_ld(&(bar)[XB_TMO])) break; if (_sp > XB_SPIN_CAP) { atomicAdd(&(bar)[XB_TMO], 1u); break; } } } } while (0)

struct XcdBarrier {
    unsigned* bar; unsigned x;
    volatile LAS unsigned* st;
};

__device__ __forceinline__ XcdBarrier xcd_barrier_post(unsigned* bar, volatile LAS unsigned* st) {
    XcdBarrier b; b.bar = bar; b.x = xb_xcc_id(); b.st = st;
    if (threadIdx.x == 0) (void)xb_add(&bar[XB_XCNT(b.x)], 1u);
    return b;
}
__device__ __forceinline__ void xcd_barrier_complete(unsigned* bar, unsigned x, unsigned& nloc, unsigned& nx) {
    const unsigned G = gridDim.x * gridDim.y * gridDim.z;
    unsigned sum, cnt, mine, sp = 0u;
    for (;;) {
        sum = 0u; cnt = 0u; mine = 0u;
#pragma unroll
        for (unsigned j = 0; j < 16; ++j) { const unsigned c = xb_ld(&bar[XB_XCNT(j)]); sum += c; cnt += (c > 0u) ? 1u : 0u; mine = (j == x) ? c : mine; }
        if (sum == G) break;
        __builtin_amdgcn_s_sleep(1);
        if ((++sp & 255u) == 0u) { if (xb_ld(&bar[XB_TMO])) break; if (sp > XB_SPIN_CAP) { atomicAdd(&bar[XB_TMO], 1u); break; } }
    }
    nloc = mine > 0u ? mine : 1u; nx = cnt > 0u ? cnt : 1u;
}

__device__ __forceinline__ void xcd_barrier(const XcdBarrier& b) {
    asm volatile("s_waitcnt vmcnt(0)" ::: "memory");
    __syncthreads();
    if (threadIdx.x == 0) {
        unsigned* bar = b.bar;
        __builtin_amdgcn_s_waitcnt(0);
        unsigned nloc = b.st[0], nx = b.st[1];
        if (nloc == 0u) { xcd_barrier_complete(bar, b.x, nloc, nx); b.st[0] = nloc; b.st[1] = nx; }
        const unsigned kbar = b.st[2]; b.st[2] = kbar + 1u;
        const unsigned old = xb_add(&bar[XB_XSUB(b.x)], 1u);
        const unsigned gen = old / nloc;
        if (old + 1u == (gen + 1u) * nloc) {
            __builtin_amdgcn_fence(__ATOMIC_RELEASE, "agent");
            asm volatile("s_waitcnt vmcnt(0)" ::: "memory");
            const unsigned og = xb_add(&bar[XB_TOP], 1u);
            const unsigned tg = og / nx;
            if (og + 1u == (tg + 1u) * nx) xb_add(&bar[XB_TOPGEN], 1u);
            else XB_SPIN(xb_ld(&bar[XB_TOPGEN]) == tg, bar);
            __builtin_amdgcn_fence(__ATOMIC_ACQUIRE, "agent");
            asm volatile("s_waitcnt vmcnt(0)" ::: "memory");
        } else {
            XB_SPIN(xb_ld(&bar[XB_TOPGEN]) == kbar, bar);
            __builtin_amdgcn_fence(__ATOMIC_ACQUIRE, "agent");
            asm volatile("s_waitcnt vmcnt(0)" ::: "memory");
        }
    }
    __syncthreads();
}

#define DI __device__ __forceinline__
typedef unsigned u32x4v __attribute__((ext_vector_type(4)));
typedef unsigned u32x2v __attribute__((ext_vector_type(2)));
typedef short s16x4 __attribute__((ext_vector_type(4)));
typedef short v4i16_t __attribute__((ext_vector_type(4)));
struct Args { const float* in[18]; float* out; unsigned char* ws; int ph_lo, ph_hi, li, pad; };
enum { I_X = 0, I_C, I_CTX, I_CCTX, I_ADAW, I_ADAB, I_NMIX, I_NMLP, I_MLWIN, I_MLBG, I_MLNORM, I_MLWOUT, I_NAWQKV, I_NARPB, I_NAWOUT, I_W1, I_W2, I_FNORM };
struct Frame {
    LAS unsigned char* lds; int tid, lane, wave, G;
    float* out; unsigned char* ws;
};
DI float bperm(float v, int src_lane) { return __builtin_bit_cast(float, __builtin_amdgcn_ds_bpermute(src_lane << 2, __builtin_bit_cast(int, v))); }
DI float wave_sum(float v, int lane) {
#pragma unroll
    for (int o = 1; o < 64; o <<= 1) v += bperm(v, lane ^ o);
    return v;
}
typedef __bf16 bf16x2_t __attribute__((ext_vector_type(2)));
typedef float f32x2_t __attribute__((ext_vector_type(2)));
DI unsigned pkbf(float lo, float hi) { const f32x2_t v = {lo, hi}; const bf16x2_t b = __builtin_convertvector(v, bf16x2_t); return __builtin_bit_cast(unsigned, b); }
DI float bf_lo(unsigned w) { return __builtin_bit_cast(float, w << 16); }
DI float bf_hi(unsigned w) { return __builtin_bit_cast(float, w & 0xffff0000u); }
DI float ex2(float x) { return __builtin_amdgcn_exp2f(x); }
DI f32x4 mfma16(bf16x8 a, bf16x8 b, f32x4 c) { return __builtin_amdgcn_mfma_f32_16x16x32_bf16(a, b, c, 0, 0, 0); }
DI s16x4 tr_read(LAS unsigned char* p) { return __builtin_bit_cast(s16x4, __builtin_amdgcn_ds_read_tr16_b64_v4i16((LAS v4i16_t*)p)); }
DI bf16x8 cat8(s16x4 lo, s16x4 hi) { return __builtin_shufflevector(lo, hi, 0, 1, 2, 3, 4, 5, 6, 7); }

template <int MODE> DI void p0_transpose_item(const float* W, int K, int Nsrc, bf16* WT, int nblk, LAS float* scr, int item, int lane) {
    const int kb = item / nblk, nb = item % nblk, k0 = 64 * kb, n0 = 32 * nb;
    int nsrc = n0 + (lane & 31); bool valid = true;
    if (MODE == 1) { if (n0 < 2048) { const int p = nsrc & 127, pp = p & 63; nsrc = (nsrc & ~127) + (p & 64) + (pp >> 1) + 32 * (pp & 1); } valid = n0 < Nsrc; }
#pragma unroll 8
    for (int i = 0; i < 32; ++i) { const int kk = 2 * i + (lane >> 5); scr[kk * 33 + (lane & 31)] = valid ? W[(size_t)(k0 + kk) * Nsrc + nsrc] : 0.f; }
    LDS_WAIT(); asm volatile("" ::: "memory");
    const int c = lane & 7;
#pragma unroll
    for (int j = 0; j < 4; ++j) { const int n = (lane >> 3) + 8 * j; const LAS float* s = scr + (8 * c) * 33 + n;
        v4u o; o.x = pkbf(s[0 * 33], s[1 * 33]); o.y = pkbf(s[2 * 33], s[3 * 33]); o.z = pkbf(s[4 * 33], s[5 * 33]); o.w = pkbf(s[6 * 33], s[7 * 33]);
        *(GAS v4u*)((GAS unsigned char*)WT + pg8::bblk_byte(n0 + n, k0 + 8 * c, K)) = o; }
    LDS_WAIT(); asm volatile("" ::: "memory");
}
DI void sincos_d(double ang, float& co, float& si) {
    const double TWO_PI = 6.283185307179586476925286766559;
    const double r = ang - TWO_PI * __builtin_rint(ang / TWO_PI), r2 = r * r;
    double s = 1.0, c = 1.0;
#pragma unroll
    for (int k = 14; k >= 1; --k) { s = 1.0 - s * r2 / (double)((2 * k) * (2 * k + 1)); c = 1.0 - c * r2 / (double)((2 * k - 1) * (2 * k)); }
    co = (float)c; si = (float)(s * r);
}
DI void p0_prologue(Frame& F, const Args& A) {
    const int gw = blockIdx.x * NWAVES + F.wave, NGW = F.G * NWAVES;
    { const int id = blockIdx.x * 512 + F.tid; if (id < 2048) { const int pos = id >> 5, j = id & 31; double iv = 1.0; for (int t = 0; t < j; ++t) iv *= 0.74989420933245582730; const float ang = (float)pos * (float)iv; float co, si; sincos_d((double)ang, co, si);
        float* R = (float*)(F.ws + WS_ROPE); R[2 * id] = co; R[2 * id + 1] = si; } }
    LAS float* scr = (LAS float*)(F.lds + F.wave * 8704);
    constexpr int T_MLIN = 32 * 200, T_SQ = 32 * 64, T_QKV = 32 * 192, T_W1 = 32 * 256, T_W2 = 128 * 64;
    constexpr int NITEMS = 2 * T_MLIN + 2 * T_SQ + 2 * T_QKV + 2 * T_SQ + 4 * T_W1 + 4 * T_W2;
    for (int it = gw; it < NITEMS; it += NGW) {
        int r = it;
        if (r < 2 * T_MLIN) { const int j = r / T_MLIN; p0_transpose_item<1>(A.in[I_MLWIN] + (size_t)j * DM * ML_NSRC, DM, ML_NSRC, (bf16*)(F.ws + WS_WML_IN) + (size_t)j * ML_NPAD * DM, 200, scr, r % T_MLIN, F.lane); continue; } r -= 2 * T_MLIN;
        if (r < 2 * T_SQ) { const int j = r / T_SQ; p0_transpose_item<0>(A.in[I_MLWOUT] + (size_t)j * DM * DM, DM, DM, (bf16*)(F.ws + WS_WML_OUT) + (size_t)j * DM * DM, 64, scr, r % T_SQ, F.lane); continue; } r -= 2 * T_SQ;
        if (r < 2 * T_QKV) { const int j = r / T_QKV; p0_transpose_item<0>(A.in[I_NAWQKV] + (size_t)j * DM * 6144, DM, 6144, (bf16*)(F.ws + WS_WNA_QKV) + (size_t)j * 6144 * DM, 192, scr, r % T_QKV, F.lane); continue; } r -= 2 * T_QKV;
        if (r < 2 * T_SQ) { const int j = r / T_SQ; p0_transpose_item<0>(A.in[I_NAWOUT] + (size_t)j * DM * DM, DM, DM, (bf16*)(F.ws + WS_WNA_OUT) + (size_t)j * DM * DM, 64, scr, r % T_SQ, F.lane); continue; } r -= 2 * T_SQ;
        if (r < 4 * T_W1) { const int j = r / T_W1; p0_transpose_item<0>(A.in[I_W1] + (size_t)j * DM * DFF, DM, DFF, (bf16*)(F.ws + WS_W1) + (size_t)j * DFF * DM, 256, scr, r % T_W1, F.lane); continue; } r -= 4 * T_W1;
        { const int j = r / T_W2; p0_transpose_item<0>(A.in[I_W2] + (size_t)j * DFF * DM, DFF, DM, (bf16*)(F.ws + WS_W2) + (size_t)j * DM * DFF, 64, scr, r % T_W2, F.lane); }
    }
    __syncthreads();
    LAS float* condT = (LAS float*)F.lds;
    for (int idx = F.tid; idx < 9 * DM; idx += 512) { const int r = idx / DM, k = idx % DM; const float v = r < 8 ? A.in[I_C][r * DM + k] : A.in[I_CCTX][k]; condT[k * 12 + r] = v / (1.f + __expf(-v)); }
    __syncthreads();
    float* PART = (float*)(F.ws + WS_PART);
    for (int it = gw; it < 4 * 48 * 32; it += NGW) {
        const int layer = it / 1536, rem = it % 1536, cc = rem >> 5, kc = rem & 31;
        const float* wp = A.in[I_ADAW] + ((size_t)layer * DM + kc * 64) * NMOD + cc * 256 + 4 * F.lane;
        f32x4 acc[9];
#pragma unroll
        for (int r = 0; r < 9; ++r) acc[r] = (f32x4){0.f, 0.f, 0.f, 0.f};
#pragma unroll 8
        for (int k = 0; k < 64; ++k) {
            const f32x4 w = *(const GAS f32x4*)(wp + (size_t)k * NMOD);
            const LAS f32x4* cp = (const LAS f32x4*)(condT + (kc * 64 + k) * 12); const f32x4 c0 = cp[0], c1 = cp[1], c2 = cp[2];
            acc[0] += w * c0[0]; acc[1] += w * c0[1]; acc[2] += w * c0[2]; acc[3] += w * c0[3];
            acc[4] += w * c1[0]; acc[5] += w * c1[1]; acc[6] += w * c1[2]; acc[7] += w * c1[3]; acc[8] += w * c2[0];
        }
#pragma unroll
        for (int r = 0; r < 9; ++r) *(GAS f32x4*)(PART + (((size_t)kc * 4 + layer) * 9 + r) * NMOD + cc * 256 + 4 * F.lane) = acc[r];
    }
}
DI void p1_mods(Frame& F, const Args& A) {
    const float* PART = (const float*)(F.ws + WS_PART); float* MODS = (float*)(F.ws + WS_MODS);
    for (int i = blockIdx.x * 512 + F.tid; i < 4 * 9 * NMOD / 4; i += F.G * 512) {
        const int e = i * 4, l = e / (9 * NMOD), c = e % NMOD;
        f32x4 s = *(const GAS f32x4*)(A.in[I_ADAB] + l * NMOD + c);
        for (int kc = 0; kc < 32; ++kc) s += *(const GAS f32x4*)(PART + (size_t)kc * 4 * 9 * NMOD + e);
        *(GAS f32x4*)(MODS + e) = s;
    }
}
template <bool COPY> DI void norm_phase(Frame& F, const float* src_lat, const float* src_ctx, const float* gain, const float* mods, int sc_off, bool do_lat, const h16* part, const float* gate_ctx, bf16* Udst, float* ssl, float* ssc) {
    float* HC = (float*)(F.ws + WS_HC);
    f32x4 A[8]; int cur = -1;
    for (int i = (do_lat ? 0 : 128) + F.wave; i < 136; i += NWAVES) {
        const bool isc = i >= 128; const int row = isc ? ML + 8 * (int)blockIdx.x + (i - 128) : 128 * (int)blockIdx.x + i; const int bidx = isc ? 8 : (row >> 12);
        if (bidx != cur) { cur = bidx; const float* mp = mods + bidx * NMOD;
#pragma unroll
            for (int k = 0; k < 8; ++k) { const int c = 4 * F.lane + 256 * k; const f32x4 g = *(const GAS f32x4*)(gain + c), sc = *(const GAS f32x4*)(mp + sc_off + c); A[k] = g * (sc + 1.f); } }
        const float* xr = isc ? src_ctx + (size_t)(row - ML) * DM : src_lat + (size_t)row * DM;
        f32x4 v[8]; float ss = 0.f;
#pragma unroll
        for (int k = 0; k < 8; ++k) v[k] = *(const GAS f32x4*)(xr + 4 * F.lane + 256 * k);
        if (!COPY && isc && part) {
            const h16* pr = part + (size_t)(row - ML) * DM + 4 * F.lane; float* hr = HC + (size_t)(row - ML) * DM + 4 * F.lane;
#pragma unroll
            for (int k = 0; k < 8; ++k) { const f32x4 p0 = __builtin_convertvector(*(const GAS h16x4*)(pr + 256 * k), f32x4), p1 = __builtin_convertvector(*(const GAS h16x4*)(pr + (size_t)MC * DM + 256 * k), f32x4), p2 = __builtin_convertvector(*(const GAS h16x4*)(pr + (size_t)2 * MC * DM + 256 * k), f32x4), p3 = __builtin_convertvector(*(const GAS h16x4*)(pr + (size_t)3 * MC * DM + 256 * k), f32x4);
                const f32x4 gt = *(const GAS f32x4*)(gate_ctx + 4 * F.lane + 256 * k); v[k] = v[k] + gt * ((p0 + p1) + (p2 + p3)); *(GAS f32x4*)(hr + 256 * k) = v[k]; }
        }
#pragma unroll
        for (int k = 0; k < 8; ++k) ss += (v[k].x * v[k].x + v[k].y * v[k].y) + (v[k].z * v[k].z + v[k].w * v[k].w);
        ss = wave_sum(ss, F.lane);
        if (F.lane == 0) { if (isc) ssc[row - ML] = ss; else ssl[row] = ss; }
        if (COPY && !isc) { h16* dr = (h16*)(F.ws + WS_H16) + (size_t)row * DM;
#pragma unroll
            for (int k = 0; k < 8; ++k) *(GAS h16x4*)(dr + 4 * F.lane + 256 * k) = __builtin_convertvector(v[k], h16x4); }
        if (COPY && isc) { float* dr = HC + (size_t)(row - ML) * DM;
#pragma unroll
            for (int k = 0; k < 8; ++k) *(GAS f32x4*)(dr + 4 * F.lane + 256 * k) = v[k]; }
#pragma unroll
        for (int k = 0; k < 8; ++k) { const f32x4 o = v[k] * A[k]; u32x2v w; w.x = pkbf(o.x, o.y); w.y = pkbf(o.z, o.w); *(GAS u32x2v*)((GAS unsigned char*)Udst + pg8::ablk_byte(row, 4 * F.lane + 256 * k, DM)) = w; }
    }
}
DI void p2_bias(Frame& F) {
    const float* MODS = (const float*)(F.ws + WS_MODS);
    LAS unsigned char* SH = F.lds;
    constexpr int SHP = (2048 + 8) * 2;
    const int fr = F.lane & 15, g = F.lane >> 4;
    { const int p = blockIdx.x & 7;
        const int layer = p >> 1, t = p & 1, j = layer >> 1; const bool is_na = (layer & 1) != 0;
        const int N = t ? DFF : (is_na ? 6144 : ML_NPAD);
        const bf16* W = t ? (const bf16*)(F.ws + WS_W1) + (size_t)layer * DFF * DM : (is_na ? (const bf16*)(F.ws + WS_WNA_QKV) + (size_t)j * 6144 * DM : (const bf16*)(F.ws + WS_WML_IN) + (size_t)j * ML_NPAD * DM);
        float* BV = t ? (float*)(F.ws + WS_BVM1) + (size_t)layer * 9 * DFF : (float*)(F.ws + WS_BVIN) + (size_t)layer * 9 * ML_NPAD;
        const float* sh = MODS + (size_t)layer * 9 * NMOD + (t ? 3 * DM : 0);
        __syncthreads();
        for (int idx = F.tid; idx < 16 * 1024; idx += 512) { const int r = idx >> 10, k2 = idx & 1023; unsigned wv = 0u; if (r < 9) { const float* s2 = sh + (size_t)r * NMOD + 2 * k2; wv = pkbf(s2[0], s2[1]); } *(LAS unsigned*)(SH + r * SHP + k2 * 4) = wv; }
        __syncthreads();
        for (int cg = (int)(blockIdx.x >> 3) * NWAVES + F.wave; cg < N / 16; cg += (F.G >> 3) * NWAVES) {
            f32x4 acc = (f32x4){0.f, 0.f, 0.f, 0.f};
#pragma unroll 8
            for (int ks = 0; ks < 64; ++ks) { const bf16x8 bw = *(const GAS bf16x8*)((const GAS unsigned char*)W + pg8::bblk_byte(cg * 16 + fr, 32 * ks + 8 * g, DM)); const bf16x8 as = *(const LAS bf16x8*)(SH + fr * SHP + (32 * ks + 8 * g) * 2); acc = mfma16(as, bw, acc); }
#pragma unroll
            for (int i = 0; i < 4; ++i) { const int r = 4 * g + i; if (r < 9) BV[(size_t)r * N + cg * 16 + fr] = acc[i]; }
        }
    }
}
DI void ml_gate_tail(Frame& F, const bf16* U, const bf16* W, float* G, const float* bgate, const float* ssl, const float* ssc, const float* bv, int rank, int nr) {
    LAS unsigned char* BL = F.lds;
    asm volatile("s_waitcnt vmcnt(0)" ::: "memory"); __syncthreads();
    for (int idx = F.tid; idx < 8192; idx += 512) { const int cg = idx >> 12, ks = (idx >> 6) & 63, l = idx & 63;
        *(LAS bf16x8*)(BL + idx * 16) = *(const GAS bf16x8*)((const GAS unsigned char*)W + pg8::bblk_byte(6144 + cg * 16 + (l & 15), 32 * ks + 8 * (l >> 4), DM)); }
    __syncthreads();
    const int fr = F.lane & 15, g = F.lane >> 4, gw = rank * NWAVES + F.wave, ngw = nr * NWAVES;
    const unsigned loff = (unsigned)(((fr * 64 + g * 16) ^ ((fr >> 3) << 5)));
    const int nrg = (MT / 16 - gw + ngw - 1) / ngw, nblk = nrg * 4;
    bf16x8 a0[16], a1[16]; f32x4 acc0 = (f32x4){0.f, 0.f, 0.f, 0.f}, acc1 = acc0;
#define GT_LOAD(dst, q) do { const int rg_ = gw + ((q) >> 2) * ngw; const GAS unsigned char* p_ = (const GAS unsigned char*)U + ((size_t)(rg_ >> 3) * (DM >> 6) + ((q) & 3) * 8) * 16384 + (unsigned)(rg_ & 7) * 2048u + loff; \
        _Pragma("unroll") for (int i_ = 0; i_ < 16; ++i_) dst[i_] = *(const GAS bf16x8*)(p_ + (i_ >> 1) * 16384 + (i_ & 1) * 1024); } while (0)
#define GT_COMP(src, q) do { const int kb_ = ((q) & 3) * 16; \
        _Pragma("unroll") for (int i4_ = 0; i4_ < 16; i4_ += 4) { bf16x8 b_[8]; \
            _Pragma("unroll") for (int j_ = 0; j_ < 4; ++j_) { b_[2 * j_] = *(const LAS bf16x8*)(BL + ((kb_ + i4_ + j_) * 64 + F.lane) * 16); b_[2 * j_ + 1] = *(const LAS bf16x8*)(BL + ((64 + kb_ + i4_ + j_) * 64 + F.lane) * 16); } \
            __builtin_amdgcn_sched_barrier(0); \
            _Pragma("unroll") for (int j_ = 0; j_ < 4; ++j_) { acc0 = mfma16(src[i4_ + j_], b_[2 * j_], acc0); acc1 = mfma16(src[i4_ + j_], b_[2 * j_ + 1], acc1); } } } while (0)
    if (nblk > 0) GT_LOAD(a0, 0);
    for (int q = 0; q < nblk; q += 2) {
        GT_LOAD(a1, q + 1);
        GT_COMP(a0, q);
        if (q + 2 < nblk) GT_LOAD(a0, q + 2);
        GT_COMP(a1, q + 1);
        if ((q & 3) == 2) {
            const int rg = gw + (q >> 2) * ngw, row0 = rg * 16 + 4 * g, bidx = row0 < ML ? (row0 >> 12) : 8;
            const float* sp = row0 < ML ? ssl + row0 : ssc + (row0 - ML);
            const float bi0 = bv[(size_t)bidx * ML_NPAD + 6144 + fr] + bgate[fr], bi1 = bv[(size_t)bidx * ML_NPAD + 6144 + 16 + fr] + bgate[16 + fr];
            const bool isf0 = ((fr >> 3) & 1) != 0;
#pragma unroll
            for (int i = 0; i < 4; ++i) { const float rstd = __builtin_amdgcn_rsqf(sp[i] * (1.f / DM) + RMS_EPS);
                float x0 = (acc0[i] * rstd + bi0) * (1.f / 15.f), x1 = (acc1[i] * rstd + bi1) * (1.f / 15.f);
                x0 = 15.f * (1.f - 2.f * __builtin_amdgcn_rcpf(__expf(2.f * x0) + 1.f)); x1 = 15.f * (1.f - 2.f * __builtin_amdgcn_rcpf(__expf(2.f * x1) + 1.f));
                if (isf0) { x0 = fminf(x0, 0.f) - log1pf(__expf(-fabsf(x0))); x1 = fminf(x1, 0.f) - log1pf(__expf(-fabsf(x1))); }
                float* gp = G + (size_t)(row0 + i) * 32; gp[fr] = x0; gp[16 + fr] = x1; }
            acc0 = (f32x4){0.f, 0.f, 0.f, 0.f}; acc1 = acc0; }
    }
#undef GT_LOAD
#undef GT_COMP
}
DI void final_norm_phase(Frame& F, const Args& AR) {
    const int rpw = ML / F.G, rbase = blockIdx.x * rpw;
    f32x4 A[8];
#pragma unroll
    for (int k = 0; k < 8; ++k) A[k] = *(const GAS f32x4*)(AR.in[I_FNORM] + 4 * F.lane + 256 * k);
    for (int i = F.wave; i < rpw; i += NWAVES) {
        float* xr = F.out + (size_t)(rbase + i) * DM; const h16* hr = (const h16*)(F.ws + WS_H16) + (size_t)(rbase + i) * DM; f32x4 v[8]; float ss = 0.f;
#pragma unroll
        for (int k = 0; k < 8; ++k) { v[k] = __builtin_convertvector(*(const GAS h16x4*)(hr + 4 * F.lane + 256 * k), f32x4); ss += (v[k].x * v[k].x + v[k].y * v[k].y) + (v[k].z * v[k].z + v[k].w * v[k].w); }
        const float rstd = 1.f / sqrtf(wave_sum(ss, F.lane) * (1.f / DM) + RMS_EPS);
#pragma unroll
        for (int k = 0; k < 8; ++k) *(GAS f32x4*)(xr + 4 * F.lane + 256 * k) = v[k] * rstd * A[k];
    }
}
DI void readout_phase(Frame& F, const float* mlnorm) {
    const bf16* HF = (const bf16*)(F.ws + WS_HF); const bf16* HB = (const bf16*)(F.ws + WS_HB); const bf16* OG = (const bf16*)(F.ws + WS_MOG); bf16* U = (bf16*)(F.ws + WS_U);
    const int gw = blockIdx.x * NWAVES + F.wave, NGW = F.G * NWAVES;
    for (int row = gw; row < MT; row += NGW) {
        const size_t ro = (size_t)row * DM;
#pragma unroll
        for (int k = 0; k < 4; ++k) {
            const int c = 8 * F.lane + 512 * k;
            const u32x4v a = *(const GAS u32x4v*)(HF + ro + c), b = *(const GAS u32x4v*)(HB + ro + c), g = *(const GAS u32x4v*)(OG + ro + c);
            const f32x4 n0 = *(const GAS f32x4*)(mlnorm + c), n1 = *(const GAS f32x4*)(mlnorm + c + 4);
            float h[8]; float ss = 0.f;
#pragma unroll
            for (int j = 0; j < 4; ++j) { h[2 * j] = bf_lo(a[j]) + bf_lo(b[j]); h[2 * j + 1] = bf_hi(a[j]) + bf_hi(b[j]); ss += h[2 * j] * h[2 * j] + h[2 * j + 1] * h[2 * j + 1]; }
#pragma unroll
            for (int o = 1; o < 32; o <<= 1) ss += bperm(ss, F.lane ^ o);
            const float rstd = 1.f / sqrtf(ss * (1.f / 256.f) + RMS_EPS);
            u32x4v w;
#pragma unroll
            for (int j = 0; j < 4; ++j) { const float nlo = j < 2 ? n0[2 * j] : n1[2 * j - 4], nhi = j < 2 ? n0[2 * j + 1] : n1[2 * j - 3];
                w[j] = pkbf(h[2 * j] * rstd * nlo * bf_lo(g[j]), h[2 * j + 1] * rstd * nhi * bf_hi(g[j])); }
            *(GAS u32x4v*)((GAS unsigned char*)U + pg8::ablk_byte(row, c, DM)) = w;
        }
    }
}

DI void swap16(float& a, float& b) { asm volatile("s_nop 1\n\tv_permlane16_swap_b32 %0, %1" : "+v"(a), "+v"(b)); }
DI void swap32(float& a, float& b) { asm volatile("s_nop 1\n\tv_permlane32_swap_b32 %0, %1" : "+v"(a), "+v"(b)); }
DI float xor16_max(float v) { float a = v, b = v; swap16(a, b); return fmaxf(a, b); }
DI float xor32_max(float v) { float a = v, b = v; swap32(a, b); return fmaxf(a, b); }
DI float xor16_sum(float v) { float a = v, b = v; swap16(a, b); return a + b; }
DI float xor32_sum(float v) { float a = v, b = v; swap32(a, b); return a + b; }
constexpr int NA_PITCH = 272, NA_VPITCH = 288, NA_TILE = 64 * NA_VPITCH, NA_RPB_OFF = 4 * NA_TILE;
DI bf16x8 na_softmax(f32x4 (&s)[2], float& m_run, float& l_run, f32x4 (&o)[8]) {
    float mx = fmaxf(fmaxf(fmaxf(s[0][0], s[0][1]), fmaxf(s[0][2], s[0][3])), fmaxf(fmaxf(s[1][0], s[1][1]), fmaxf(s[1][2], s[1][3])));
    mx = xor16_max(mx); mx = xor32_max(mx);
    const float m_new = mx > m_run + 8.f ? mx : m_run;
    const bool moved = m_new != m_run;
    float ls = 0.f;
#pragma unroll
    for (int kg = 0; kg < 2; ++kg)
#pragma unroll
        for (int i = 0; i < 4; ++i) { const float p = ex2(s[kg][i] - m_new); s[kg][i] = p; ls += p; }
    if (__builtin_amdgcn_ballot_w64(moved) != 0ull) {
        const float alpha = ex2(m_run - m_new); l_run *= alpha;
#pragma unroll
        for (int d = 0; d < 8; ++d) o[d] = o[d] * alpha; }
    l_run += ls; m_run = m_new;
    u32x4v pw; pw.x = pkbf(s[0][0], s[0][1]); pw.y = pkbf(s[0][2], s[0][3]); pw.z = pkbf(s[1][0], s[1][1]); pw.w = pkbf(s[1][2], s[1][3]);
    return __builtin_bit_cast(bf16x8, pw);
}
DI void na_phase(Frame& F, const float* rpb, bool need_ctx) {
    const bf16* QKV = (const bf16*)(F.ws + WS_QKV); bf16* AO = (bf16*)(F.ws + WS_U);
    const int w = F.wave, lane = F.lane, fr = lane & 15, g = lane >> 4, tq = (lane >> 2) & 3, tp = lane & 3;
    LAS float* rpbs = (LAS float*)(F.lds + NA_RPB_OFF);
    const int nunits = 2048 + (need_ctx ? 128 : 0);
    for (int u = blockIdx.x; u < nunits; u += F.G) {
        int b, h, ntw, band_lo = 0, ra = 0, c = 0, rsA = 0, rsB = 0, cs = 0, cstart = 0; size_t qgA, qgB;
        if (u < 2048) { const int x = u & 7, rq = (u >> 3) & 15, y = u >> 7, bh = y * 8 + x; b = bh >> 4; h = bh & 15;
            const int r0 = 4 * rq; ra = r0 + 2 * (w >> 2); const int cb = w & 3; c = 16 * cb + fr; qgA = (size_t)b * SEQ + ra * 64 + c; qgB = qgA + 64;
            rsA = min(max(ra - 4, 0), 56); rsB = min(max(ra - 3, 0), 56); band_lo = min(max(r0 - 4, 0), 56); const int band_hi = min(max(r0 - 1, 0), 56) + 7; ntw = band_hi - band_lo + 1;
            cstart = min(max(c - 8, 0), 48); cs = cb == 0 ? 0 : (cb == 1 ? 8 : (cb == 2 ? 24 : 32));
        } else { const int uc = u - 2048; b = uc >> 4; h = uc & 15; qgA = (size_t)ML + b * CTXL + 32 * w + fr; qgB = qgA + 16; ntw = 0; }
        const int NT = ntw + 4;
        bf16x8 qfA[4], qfB[4];
#pragma unroll
        for (int ks = 0; ks < 4; ++ks) { qfA[ks] = *(const GAS bf16x8*)(QKV + qgA * 6144 + h * 128 + 32 * ks + 8 * g); qfB[ks] = *(const GAS bf16x8*)(QKV + qgB * 6144 + h * 128 + 32 * ks + 8 * g); }
        if (ntw) for (int i = F.tid; i < 466; i += 512) rpbs[i] = i < 465 ? rpb[h * 465 + i] * LOG2E : -INFINITY;
        int boff[8]; int bvalid = 0;
#pragma unroll
        for (int k = 0; k < 8; ++k) { const int kc = cs + 16 * (k >> 2) + 4 * g + (k & 3); boff[k] = kc - c + 15; if (kc >= cstart && kc < cstart + 16) bvalid |= 1 << k; }
        f32x4 oA[8], oB[8];
#pragma unroll
        for (int d = 0; d < 8; ++d) { oA[d] = (f32x4){0.f, 0.f, 0.f, 0.f}; oB[d] = (f32x4){0.f, 0.f, 0.f, 0.f}; }
        float mA = -1e30f, lA = 0.f, mB = -1e30f, lB = 0.f;
        u32x4v pk[2], pv[2];
#define NA_TILE_BASE(tt) ((tt) < ntw ? (size_t)b * SEQ + (band_lo + (tt)) * 64 : (size_t)ML + b * CTXL + 64 * ((tt) - ntw))
#define NA_REQ(tt) do { const size_t base_ = NA_TILE_BASE(tt); _Pragma("unroll") for (int i = 0; i < 2; ++i) { const int id = F.tid + 512 * i, row = id >> 4, off = id & 15; \
            const bf16* p_ = QKV + (base_ + row) * 6144 + 2048 + h * 128 + off * 8; pk[i] = *(const GAS u32x4v*)p_; pv[i] = *(const GAS u32x4v*)(p_ + 2048); } } while (0)
#define NA_PUT(tt) do { LAS unsigned char* Kn_ = F.lds + ((tt) & 1) * 2 * NA_TILE; _Pragma("unroll") for (int i = 0; i < 2; ++i) { const int id = F.tid + 512 * i, row = id >> 4, off = id & 15; \
            *(LAS u32x4v*)(Kn_ + row * NA_PITCH + off * 16) = pk[i]; *(LAS u32x4v*)(Kn_ + NA_TILE + row * NA_VPITCH + off * 16) = pv[i]; } } while (0)
        NA_REQ(0); NA_PUT(0);
        __syncthreads();
        for (int t = 0; t < NT; ++t) {
            LAS unsigned char* Kb = F.lds + (t & 1) * 2 * NA_TILE; LAS unsigned char* Vb = Kb + NA_TILE;
            if (t + 1 < NT) NA_REQ(t + 1);
            const bool win = t < ntw; const int kr = band_lo + t;
            const bool actA = !win || (kr >= rsA && kr <= rsA + 7), actB = !win || (kr >= rsB && kr <= rsB + 7);
            if (actA || actB) {
                const int nstep = win ? 1 : 2; const int browA = (kr - ra + 7) * 31, browB = browA - 31;
#define NA_STEP(DOA, DOB) do { \
                    const int ko = win ? cs : 32 * st; \
                    f32x4 sA[2], sB[2]; \
                    _Pragma("unroll") for (int kg = 0; kg < 2; ++kg) { sA[kg] = (f32x4){0.f, 0.f, 0.f, 0.f}; sB[kg] = (f32x4){0.f, 0.f, 0.f, 0.f}; } \
                    if (win) { _Pragma("unroll") for (int k = 0; k < 8; ++k) { const bool v = (bvalid >> k) & 1; sA[k >> 2][k & 3] = rpbs[v && actA ? browA + boff[k] : 465]; sB[k >> 2][k & 3] = rpbs[v && actB ? browB + boff[k] : 465]; } } \
                    { bf16x8 kf[2][4]; \
                      _Pragma("unroll") for (int kg = 0; kg < 2; ++kg) _Pragma("unroll") for (int ks = 0; ks < 4; ++ks) kf[kg][ks] = *(const LAS bf16x8*)(Kb + (ko + 16 * kg + fr) * NA_PITCH + (32 * ks + 8 * g) * 2); \
                      _Pragma("unroll") for (int kg = 0; kg < 2; ++kg) _Pragma("unroll") for (int ks = 0; ks < 4; ++ks) { if (DOA) sA[kg] = mfma16(kf[kg][ks], qfA[ks], sA[kg]); if (DOB) sB[kg] = mfma16(kf[kg][ks], qfB[ks], sB[kg]); } } \
                    __builtin_amdgcn_sched_barrier(0); \
                    bf16x8 pbA, pbB; bf16x8 vf[8]; \
                    _Pragma("unroll") for (int d = 0; d < 8; ++d) { const s16x4 lo = tr_read(Vb + (ko + 4 * g + tq) * NA_VPITCH + 32 * d + 8 * tp), hi = tr_read(Vb + (ko + 16 + 4 * g + tq) * NA_VPITCH + 32 * d + 8 * tp); vf[d] = cat8(lo, hi); } \
                    pbA = na_softmax(sA, mA, lA, oA); \
                    __builtin_amdgcn_sched_barrier(0); \
                    _Pragma("unroll") for (int d = 0; d < 8; ++d) oA[d] = mfma16(vf[d], pbA, oA[d]);     \
                    __builtin_amdgcn_sched_barrier(0); \
                    pbB = na_softmax(sB, mB, lB, oB); \
                    __builtin_amdgcn_sched_barrier(0); \
                    _Pragma("unroll") for (int d = 0; d < 8; ++d) oB[d] = mfma16(vf[d], pbB, oB[d]); \
                    __builtin_amdgcn_sched_barrier(0); } while (0)
                for (int st = 0; st < nstep; ++st) {
                    NA_STEP(1, 1);
                }
#undef NA_STEP
            }
            if (t + 1 < NT) { NA_PUT(t + 1);
#ifdef NA_DUP_STAGE
              asm volatile("" ::: "memory"); NA_PUT(t + 1);
#endif
            }
#ifdef NA_DUP_BAR
            __syncthreads();
#endif
            __syncthreads();
        }
#undef NA_TILE_BASE
#undef NA_REQ
#undef NA_PUT
        { const float inv = 1.f / xor32_sum(xor16_sum(lA));
#pragma unroll
          for (int d = 0; d < 8; ++d) { u32x2v wv; wv.x = pkbf(oA[d][0] * inv, oA[d][1] * inv); wv.y = pkbf(oA[d][2] * inv, oA[d][3] * inv); *(GAS u32x2v*)((GAS unsigned char*)AO + pg8::ablk_byte((int)qgA, h * 128 + 16 * d + 4 * g, DM)) = wv; } }
        { const float inv = 1.f / xor32_sum(xor16_sum(lB));
#pragma unroll
          for (int d = 0; d < 8; ++d) { u32x2v wv; wv.x = pkbf(oB[d][0] * inv, oB[d][1] * inv); wv.y = pkbf(oB[d][2] * inv, oB[d][3] * inv); *(GAS u32x2v*)((GAS unsigned char*)AO + pg8::ablk_byte((int)qgB, h * 128 + 16 * d + 4 * g, DM)) = wv; } }
    }
}

constexpr int SC_P = 272, SC_BUF = 52224, SC_KO = 17408, SC_VO = 34816, SC_S = 104448, SC_SP = 144, SC_TB0 = 113664, SC_TBS = 1536;
constexpr int SC_NF = 116736, SC_NBF = 117248, SC_QN = 117504, SC_RS = 118016;
constexpr int T_E2 = 0, T_M2 = 256, T_WST = 512, T_NMS = 768, T_WK = 1024, T_SCAL = 1280;
constexpr size_t WS_GT = WS_END + 1 * MiB;
DI float rdlane(float v, int l) { return __builtin_bit_cast(float, __builtin_amdgcn_readlane(__builtin_bit_cast(int, v), l)); }
DI float ld_sc1(const float* p) { return __builtin_bit_cast(float, __hip_atomic_load((const unsigned*)p, __ATOMIC_RELAXED, __HIP_MEMORY_SCOPE_AGENT)); }
DI size_t scan_row(int b, int dir, int q) { return q < 4 ? (size_t)ML + b * CTXL + 64 * (dir ? 3 - q : q) : (size_t)b * SEQ + 64 * (dir ? 63 - (q - 4) : (q - 4)); }
DI void scan_phase(Frame& F) {
    const bf16* Qg = (const bf16*)(F.ws + WS_MQ); const bf16* Kg = (const bf16*)(F.ws + WS_MK); const bf16* Vg = (const bf16*)(F.ws + WS_MV); const float* Gg = (const float*)(F.ws + WS_MG);
    const int w = F.wave, lane = F.lane, fr = lane & 15, g = lane >> 4, tq = (lane >> 2) & 3, tp = lane & 3;
    LAS unsigned char* L = F.lds;
    for (int u = blockIdx.x; u < 256; u += F.G) {
        const int x = u & 7, y = u >> 3, eh = y & 1, pi = (y >> 1) * 8 + x, dir = pi & 1, bh = pi >> 1, b = bh >> 3, hd = bh & 7;
        bf16* Hg = (bf16*)(F.ws + (dir ? WS_HB : WS_HF));
        float* GT = (float*)(F.ws + WS_GT) + (size_t)u * 68 * 384;
        { LAS float* TB = (LAS float*)L; LAS float* TE = TB + 68 * 64; LAS float* TPM = TE + 68 * 64; LAS float* BT = TPM + 68 * 64; LAS float* EM = BT + 68; LAS float* MC = EM + 68;
          { const int o = dir ? 63 - lane : lane;
            float gi[9], gf[9];
#pragma unroll
            for (int k = 0; k < 9; ++k) { const int c = w + 8 * k; if (c < 68) { const float* gp = Gg + (scan_row(b, dir, c) + o) * 32 + dir * 16 + hd; gi[k] = gp[0]; gf[k] = gp[8]; } else { gi[k] = 0.f; gf[k] = 0.f; } }
#pragma unroll
            for (int k = 0; k < 9; ++k) { const int c = w + 8 * k; if (c < 68) { float bcs = gf[k];
#pragma unroll
                for (int d = 1; d < 64; d <<= 1) { const float t = bperm(bcs, lane - d); if (lane >= d) bcs += t; }
                const float e = gi[k] - bcs; float pm = e;
#pragma unroll
                for (int d = 1; d < 64; d <<= 1) { const float t = bperm(pm, lane - d); if (lane >= d) pm = fmaxf(pm, t); }
                TB[c * 64 + o] = bcs; TE[c * 64 + o] = e; TPM[c * 64 + o] = pm; if (lane == 63) { BT[c] = bcs; EM[c] = pm; } } } }
          __syncthreads();
          if (w == 0) {
              const float a0 = BT[lane], e0 = EM[lane], a1 = lane < 4 ? BT[64 + lane] : 0.f, e1 = lane < 4 ? EM[64 + lane] : 0.f;
              float m = 0.f, mc0 = 0.f, mc1 = 0.f;
#pragma unroll
              for (int c = 0; c < 64; ++c) { mc0 = lane == c ? m : mc0; m = rdlane(a0, c) + fmaxf(m, rdlane(e0, c)); }
#pragma unroll
              for (int c = 0; c < 4; ++c) { mc1 = lane == c ? m : mc1; m = rdlane(a1, c) + fmaxf(m, rdlane(e1, c)); }
              MC[lane] = mc0; if (lane < 4) MC[64 + lane] = mc1; }
          __syncthreads();
          for (int idx = F.tid; idx < 68 * 64; idx += 512) { const int c = idx >> 6, o = idx & 63; const float m = MC[c], Ml = fmaxf(m, EM[c]), bb = TB[idx], e = TE[idx], M = fmaxf(m, TPM[idx]);
              float* gt = GT + c * 384 + o; gt[0] = e * LOG2E; gt[64] = M * LOG2E; gt[128] = __expf(m - M); gt[192] = -(bb + M) * LOG2E; gt[256] = __expf(e - Ml); if (o == 0) gt[320] = __expf(m - Ml); }
          asm volatile("s_waitcnt vmcnt(0)" ::: "memory"); __syncthreads(); }
        f32x4 C[8];
#pragma unroll
        for (int d = 0; d < 8; ++d) C[d] = (f32x4){0.f, 0.f, 0.f, 0.f};
        if (F.tid < 128) { ((LAS float*)(L + SC_NF))[F.tid] = 0.f; ((LAS unsigned short*)(L + SC_NBF))[F.tid] = 0; }
        u32x4v pq[2], pk[2], pv[2]; float tb[6];
#define SC_REQUEST(qq) do { const size_t r1_ = scan_row(b, dir, (qq)); \
        _Pragma("unroll") for (int i = 0; i < 2; ++i) { const int id = F.tid + 512 * i, row = id >> 4, off = id & 15; \
            pq[i] = *(const GAS u32x4v*)(Qg + (r1_ + row) * 1024 + hd * 128 + off * 8); pk[i] = *(const GAS u32x4v*)(Kg + (r1_ + row) * 1024 + hd * 128 + off * 8); \
            pv[i] = *(const GAS u32x4v*)(Vg + (r1_ + row) * 2048 + hd * 256 + eh * 128 + off * 8); } \
        if (w == 0) { const float* gt = GT + (qq) * 384 + lane; _Pragma("unroll") for (int k = 0; k < 5; ++k) tb[k] = ld_sc1(gt + 64 * k); tb[5] = ld_sc1(GT + (qq) * 384 + 320); } } while (0)
#define SC_STAGE(bufi) do { LAS unsigned char* B_ = L + (bufi) * SC_BUF; \
        _Pragma("unroll") for (int i = 0; i < 2; ++i) { const int id = F.tid + 512 * i, row = id >> 4, off = id & 15; \
            *(LAS u32x4v*)(B_ + row * SC_P + off * 16) = pq[i]; *(LAS u32x4v*)(B_ + SC_KO + row * SC_P + off * 16) = pk[i]; *(LAS u32x4v*)(B_ + SC_VO + row * SC_P + off * 16) = pv[i]; } \
        if (w == 0) { LAS float* T_ = (LAS float*)(L + SC_TB0 + (bufi) * SC_TBS); _Pragma("unroll") for (int k = 0; k < 5; ++k) T_[64 * k + lane] = tb[k]; if (lane == 0) T_[320] = tb[5]; } } while (0)
        SC_REQUEST(0); SC_STAGE(0); SC_REQUEST(1);
        __syncthreads();
        for (int q = 0; q < 68; ++q) {
            const int cur = q & 1; int bo_ = cur * SC_BUF, to_ = SC_TB0 + cur * SC_TBS; asm volatile("" : "+s"(bo_), "+s"(to_));
            LAS unsigned char* Bq = L + bo_; LAS unsigned char* Tq = L + to_; int so_ = SC_S; asm volatile("" : "+s"(so_)); LAS unsigned char* Lq = L + so_ - SC_S;
            const size_t row0 = scan_row(b, dir, q);
#ifdef SCAN_DUP_A
            _Pragma("unroll 1") for (int dupa = 0; dupa < 2; ++dupa)
#endif
            { const int st = w & 3, jh = w >> 2; asm volatile("" ::: "memory");
              bf16x8 qf[4];
#pragma unroll
              for (int ks = 0; ks < 4; ++ks) qf[ks] = *(const LAS bf16x8*)(Bq + (16 * st + fr) * SC_P + (32 * ks + 8 * g) * 2);
              const float Ms = ((const LAS float*)(Tq + T_M2))[16 * st + fr];
#pragma unroll
              for (int jj = 0; jj < 2; ++jj) { const int jt = 2 * jh + jj; f32x4 a = (f32x4){0.f, 0.f, 0.f, 0.f};
#pragma unroll
                  for (int ks = 0; ks < 4; ++ks) { const bf16x8 kf = *(const LAS bf16x8*)(Bq + SC_KO + (16 * jt + fr) * SC_P + (32 * ks + 8 * g) * 2); a = mfma16(kf, qf[ks], a); }
                  const f32x4 e4 = *(const LAS f32x4*)(Tq + T_E2 + (16 * jt + 4 * g) * 4); float rs = 0.f;
#pragma unroll
                  for (int i = 0; i < 4; ++i) { const int j = 16 * jt + 4 * g + i, s = 16 * st + fr; const bool causal = dir ? (j >= s) : (j <= s);
                      const float wgt = causal ? ex2(e4[i] - Ms) : 0.f; a[i] = a[i] * wgt; rs += a[i]; }
                  rs = xor32_sum(xor16_sum(rs));
                  if (g == 0) ((LAS float*)(Lq + SC_RS))[jt * 64 + 16 * st + fr] = rs;
                  u32x2v sw; sw.x = pkbf(a[0], a[1]); sw.y = pkbf(a[2], a[3]);
                  *(LAS u32x2v*)(Lq + SC_S + (16 * st + fr) * SC_SP + (16 * jt + 4 * g) * 2) = sw; }
              { f32x4 a = (f32x4){0.f, 0.f, 0.f, 0.f};
#pragma unroll
                for (int kk = 0; kk < 2; ++kk) { const int ks = 2 * jh + kk; const bf16x8 nf = *(const LAS bf16x8*)(Lq + SC_NBF + (32 * ks + 8 * g) * 2); const bf16x8 qk = *(const LAS bf16x8*)(Bq + (16 * st + fr) * SC_P + (32 * ks + 8 * g) * 2); a = mfma16(nf, qk, a); }
                if (g == 0) ((LAS float*)(Lq + SC_QN))[jh * 64 + 16 * st + fr] = a[0]; } }
            __syncthreads();
            if (q + 1 < 68) { SC_STAGE(cur ^ 1);
#ifdef SCAN_DUP_STAGE
              asm volatile("" ::: "memory"); SC_STAGE(cur ^ 1);
#endif
            }
#define SC_LDQA(dst, s4) do { const LAS unsigned char* qp_ = Bq + (16 * (s4) + fr) * SC_P; _Pragma("unroll") for (int ks = 0; ks < 4; ++ks) { \
                const u32x2v lo_ = *(const LAS u32x2v*)(qp_ + (32 * ks + 4 * g) * 2), hi_ = *(const LAS u32x2v*)(qp_ + (32 * ks + 16 + 4 * g) * 2); \
                u32x4v aw_; aw_.x = lo_.x; aw_.y = lo_.y; aw_.z = hi_.x; aw_.w = hi_.y; dst[ks] = __builtin_bit_cast(bf16x8, aw_); } } while (0)
#define SC_LDKT(dst, d) do { _Pragma("unroll") for (int k2 = 0; k2 < 2; ++k2) { const s16x4 lo_ = tr_read(Bq + SC_KO + (32 * k2 + 8 * g + tq) * SC_P + 32 * (d) + 8 * tp), hi_ = tr_read(Bq + SC_KO + (32 * k2 + 8 * g + 4 + tq) * SC_P + 32 * (d) + 8 * tp); dst[k2] = cat8(lo_, hi_); } } while (0)
            bf16x8 vf[2];
#pragma unroll
            for (int k2 = 0; k2 < 2; ++k2) { const s16x4 lo = tr_read(Bq + SC_VO + (32 * k2 + 8 * g + tq) * SC_P + 32 * w + 8 * tp), hi = tr_read(Bq + SC_VO + (32 * k2 + 8 * g + 4 + tq) * SC_P + 32 * w + 8 * tp); vf[k2] = cat8(lo, hi); }
            bf16x8 qa0[4], qa1[4], qa2[4], qa3[4];
            SC_LDQA(qa0, 0); SC_LDQA(qa1, 1);
            bf16x8 cb[4];
#pragma unroll
            for (int ks = 0; ks < 4; ++ks) { u32x4v cw; cw.x = pkbf(C[2 * ks][0], C[2 * ks][1]); cw.y = pkbf(C[2 * ks][2], C[2 * ks][3]); cw.z = pkbf(C[2 * ks + 1][0], C[2 * ks + 1][1]); cw.w = pkbf(C[2 * ks + 1][2], C[2 * ks + 1][3]); cb[ks] = __builtin_bit_cast(bf16x8, cw); }
            SC_LDQA(qa2, 2); SC_LDQA(qa3, 3);
            __builtin_amdgcn_sched_barrier(0);
            f32x4 yv[4];
#pragma unroll
            for (int s4 = 0; s4 < 4; ++s4) yv[s4] = (f32x4){0.f, 0.f, 0.f, 0.f};
#pragma unroll
            for (int ks = 0; ks < 4; ++ks) { yv[0] = mfma16(cb[ks], qa0[ks], yv[0]); yv[1] = mfma16(cb[ks], qa1[ks], yv[1]); }
            bf16x8 sf[4][2];
#pragma unroll
            for (int s4 = 0; s4 < 4; ++s4)
#pragma unroll
                for (int k2 = 0; k2 < 2; ++k2) sf[s4][k2] = *(const LAS bf16x8*)(Lq + SC_S + (16 * s4 + fr) * SC_SP + (32 * k2 + 8 * g) * 2);
            __builtin_amdgcn_sched_barrier(0);
#pragma unroll
            for (int ks = 0; ks < 4; ++ks) { yv[2] = mfma16(cb[ks], qa2[ks], yv[2]); yv[3] = mfma16(cb[ks], qa3[ks], yv[3]); }
            float qn[4], rsum[4], wst[4], nm[4];
#pragma unroll
            for (int s4 = 0; s4 < 4; ++s4) { const int s = 16 * s4 + fr;
                qn[s4] = ((const LAS float*)(Lq + SC_QN))[s] + ((const LAS float*)(Lq + SC_QN))[64 + s];
                rsum[s4] = (((const LAS float*)(Lq + SC_RS))[s] + ((const LAS float*)(Lq + SC_RS))[64 + s]) + (((const LAS float*)(Lq + SC_RS))[128 + s] + ((const LAS float*)(Lq + SC_RS))[192 + s]);
                wst[s4] = ((const LAS float*)(Tq + T_WST))[s]; nm[s4] = ((const LAS float*)(Tq + T_NMS))[s]; }
            bf16x8 kta[4][2];
#pragma unroll
            for (int d = 0; d < 4; ++d) SC_LDKT(kta[d], d);
            __builtin_amdgcn_sched_barrier(0);
            bf16* hrow = Hg + (row0 + fr) * DM + hd * 256 + eh * 128 + 16 * w + 4 * g;
#pragma unroll
            for (int s4 = 0; s4 < 4; ++s4) {
                yv[s4] = yv[s4] * wst[s4];
#pragma unroll
                for (int k2 = 0; k2 < 2; ++k2) yv[s4] = mfma16(vf[k2], sf[s4][k2], yv[s4]);
                const float den = wst[s4] * qn[s4] + rsum[s4], rinv = __builtin_amdgcn_rcpf(fmaxf(fabsf(den), ex2(nm[s4])));
                u32x2v hw; hw.x = pkbf(yv[s4][0] * rinv, yv[s4][1] * rinv); hw.y = pkbf(yv[s4][2] * rinv, yv[s4][3] * rinv);
                *(GAS u32x2v*)(hrow + (size_t)(16 * s4) * DM) = hw;
            }
            const float decay = ((const LAS float*)(Tq + T_SCAL))[0];
            bf16x8 vw[2], wkf[2];
#pragma unroll
            for (int k2 = 0; k2 < 2; ++k2) { const f32x4 wa = *(const LAS f32x4*)(Tq + T_WK + (32 * k2 + 8 * g) * 4), wb = *(const LAS f32x4*)(Tq + T_WK + (32 * k2 + 8 * g + 4) * 4);
                const u32x4v vu = __builtin_bit_cast(u32x4v, vf[k2]); u32x4v o, ww;
                o.x = pkbf(bf_lo(vu.x) * wa[0], bf_hi(vu.x) * wa[1]); o.y = pkbf(bf_lo(vu.y) * wa[2], bf_hi(vu.y) * wa[3]); o.z = pkbf(bf_lo(vu.z) * wb[0], bf_hi(vu.z) * wb[1]); o.w = pkbf(bf_lo(vu.w) * wb[2], bf_hi(vu.w) * wb[3]);
                ww.x = pkbf(wa[0], wa[1]); ww.y = pkbf(wa[2], wa[3]); ww.z = pkbf(wb[0], wb[1]); ww.w = pkbf(wb[2], wb[3]);
                vw[k2] = __builtin_bit_cast(bf16x8, o); wkf[k2] = __builtin_bit_cast(bf16x8, ww); }
            bf16x8 ktb[4][2], ktn[2];
#pragma unroll
            for (int d = 0; d < 4; ++d) SC_LDKT(ktb[d], d + 4);
            SC_LDKT(ktn, w);
            __builtin_amdgcn_sched_barrier(0);
#pragma unroll
            for (int d = 0; d < 4; ++d) { C[d] = C[d] * decay;
#pragma unroll
                for (int k2 = 0; k2 < 2; ++k2) C[d] = mfma16(kta[d][k2], vw[k2], C[d]); }
            __builtin_amdgcn_sched_barrier(0);
#pragma unroll
            for (int d = 0; d < 4; ++d) { C[d + 4] = C[d + 4] * decay;
#pragma unroll
                for (int k2 = 0; k2 < 2; ++k2) C[d + 4] = mfma16(ktb[d][k2], vw[k2], C[d + 4]); }
            f32x4 nacc = (f32x4){0.f, 0.f, 0.f, 0.f};
#pragma unroll
            for (int k2 = 0; k2 < 2; ++k2) nacc = mfma16(ktn[k2], wkf[k2], nacc);
            if (fr == 0) { LAS float* nfp = (LAS float*)(Lq + SC_NF) + 16 * w + 4 * g; const f32x4 nold = *(LAS f32x4*)nfp; const f32x4 nn = nold * decay + nacc; *(LAS f32x4*)nfp = nn;
                u32x2v nb; nb.x = pkbf(nn[0], nn[1]); nb.y = pkbf(nn[2], nn[3]); *(LAS u32x2v*)(Lq + SC_NBF + (16 * w + 4 * g) * 2) = nb; }
            if (q + 2 < 68) SC_REQUEST(q + 2);
#undef SC_LDQA
#undef SC_LDKT
            __syncthreads();
        }
#undef SC_REQUEST
#undef SC_STAGE
    }
}


constexpr int N_PHASES = 3 + 8 * DEPTH + 1;
#ifndef REP_P0
#define REP_P0 1
#endif
#ifndef REP_SCAN
#define REP_SCAN 1
#endif
#ifndef REP_NA
#define REP_NA 1
#endif
#ifndef REP_NORM
#define REP_NORM 1
#endif
#ifndef REP_RO
#define REP_RO 1
#endif
#ifndef REP_MLP1
#define REP_MLP1 1
#endif
#ifndef PROBE_DUMMY
#define PROBE_DUMMY 0
#endif
#ifndef PROBE_LAYER_MASK
#define PROBE_LAYER_MASK 15
#endif
#ifndef DBG_DEPTH
#define DBG_DEPTH DEPTH
#endif
__global__ void __launch_bounds__(NWAVES * 64, 2) fwd(Args args) {
    extern __shared__ __attribute__((aligned(16))) unsigned char lds[];
    Frame F;
    F.lds = (LAS unsigned char*)lds; F.tid = threadIdx.x; F.lane = F.tid & 63; F.wave = __builtin_amdgcn_readfirstlane(F.tid >> 6); F.G = gridDim.x;
    F.out = args.out; F.ws = args.ws;
    volatile LAS unsigned* MISC = (volatile LAS unsigned*)(F.lds + MISC_OFF);
    for (int u = F.tid; u < (LDS_BYTES - LDSCTL_OFF) / 4; u += NWAVES * 64) ((LAS unsigned*)(F.lds + LDSCTL_OFF))[u] = 0u;
    __syncthreads();
    const int wave_s = __builtin_amdgcn_readfirstlane(threadIdx.x >> 6);
    const int lo = args.ph_lo, hi = args.ph_hi;
    unsigned* barw = (unsigned*)(F.ws + WS_CTL) + CW_BAR + args.li * XCD_BAR_WORDS;
    XcdBarrier bar; bar.bar = barw; bar.x = 0; bar.st = nullptr;
    if (hi - lo > 1) bar = xcd_barrier_post(barw, MISC + 8);
#define FRESH() do { int wv_ = wave_s; asm volatile("" : "+s"(wv_)); unsigned z_ = 0u; asm volatile("" : "+s"(z_)); int l_ = (int)__builtin_amdgcn_mbcnt_hi(~0u, __builtin_amdgcn_mbcnt_lo(~0u, z_)); asm volatile("" : "+v"(l_)); F.lane = l_; F.wave = wv_; F.tid = wv_ * 64 + l_; \
    size_t zo_ = 0; asm volatile("" : "+s"(zo_)); F.ws = args.ws + zo_; F.out = args.out + zo_; } while (0)
#ifdef PROBE_XLOAD
#define XPROBE_SET E.xprobe = args.in[I_X]
#else
#define XPROBE_SET
#endif
#ifndef WGM_RES
#define WGM_RES 4
#endif
#define RUN(k) (lo <= (k) && (k) < hi)
#ifdef PROBE_WAIT
    unsigned long long wait_acc = 0ull;
#define SEAM(k) do { if (RUN(k) && RUN((k) + 1)) { const unsigned long long t0_ = __builtin_amdgcn_s_memrealtime(); xcd_barrier(bar); if (PROBE_WAIT < 0 || ((k) >= 3 && ((k) - 3) % 8 == PROBE_WAIT)) wait_acc += __builtin_amdgcn_s_memrealtime() - t0_; } } while (0)
#else
#define SEAM(k) do { if (RUN(k) && RUN((k) + 1)) xcd_barrier(bar); } while (0)
#endif
    LAS unsigned char* ring = F.lds;
#define U ((bf16*)(F.ws + WS_U))
#define HC ((float*)(F.ws + WS_HC))
#define MODS ((const float*)(F.ws + WS_MODS))
#define U2 ((bf16*)(void*)F.out)
#define H16 ((h16*)(F.ws + WS_H16))
#define SSL_A ((float*)(F.ws + WS_CTL + CTL_SSL_A))
#define SSL_B ((float*)(F.ws + WS_CTL + CTL_SSL_B))
#define SSC_A ((float*)(F.ws + WS_CTL + CTL_SSC_A))
#define SSC_B ((float*)(F.ws + WS_CTL + CTL_SSC_B))
#define ZERO_SS(p) do { if (F.tid < 128) (p)[128 * (int)blockIdx.x + F.tid] = 0.f; } while (0)

    #ifndef NO_P0
    if (RUN(0)) { _Pragma("unroll 1") for (int rep = 0; rep < REP_P0; ++rep) { FRESH(); p0_prologue(F, args); __syncthreads(); } }
#endif
    SEAM(0);
    if (RUN(1)) { FRESH(); p1_mods(F, args); } SEAM(1);
    if (RUN(2)) { FRESH(); p2_bias(F); }

    for (int layer = 0; layer < DBG_DEPTH; ++layer) {
        const int pb = 3 + 8 * layer, j = layer >> 1; const bool is_na = (layer & 1) != 0, need_ctx = layer < DEPTH - 1;
        const int mrows = need_ctx ? MT : ML;
#define mods (MODS + (size_t)layer * 9 * NMOD)
        if (RUN(pb + 0)) { _Pragma("unroll 1") for (int rep = 0; rep < REP_NORM; ++rep) { FRESH();
            if (layer == 0) norm_phase<true>(F, args.in[I_X], args.in[I_CTX], args.in[I_NMIX], mods, DM, true, nullptr, nullptr, U, SSL_B, SSC_B);
            else norm_phase<false>(F, F.out, HC, args.in[I_NMIX] + layer * DM, mods, DM, false, (const h16*)(F.ws + WS_PC), MODS + ((size_t)(layer - 1) * 9 + 8) * NMOD + 5 * DM, U, SSL_B, SSC_B); } }
        SEAM(pb + 0);
        if (RUN(pb + 1)) { FRESH();
            if (!is_na) {
                pg8::Gemm g{U, (const bf16*)(F.ws + WS_WML_IN) + (size_t)j * ML_NPAD * DM, MT, ML_NPAD, DM, DM, 1, 1}; pg8::Order8 S; S.init(MT, 6144, F.G, (int)blockIdx.x); S.rev = layer > 0;
                pg8::EpiMl E{(bf16*)(F.ws + WS_MQ), (bf16*)(F.ws + WS_MK), (bf16*)(F.ws + WS_MV), (bf16*)(F.ws + WS_MOG), (float*)(F.ws + WS_MG), args.in[I_MLBG] + j * 32, (const PG8_LAS unsigned char*)(F.lds + ROPE_LDS_OFF), pg8::NormIn{SSL_B, SSC_B, (const float*)(F.ws + WS_BVIN) + (size_t)layer * 9 * ML_NPAD, ML_NPAD}};
                { const f32x4* src = (const f32x4*)(F.ws + WS_ROPE); for (int e = F.tid; e < 1024; e += NWAVES * 64) *(LAS f32x4*)(F.lds + ROPE_LDS_OFF + (e >> 4) * ROPE_LDS_PITCH + (e & 15) * 16) = src[e]; __syncthreads(); }
#ifndef NO_G1
                pg8::gemm_phase<pg8::EpiMl, pg8::Order8, true, true>(ring, g, S, E, F.tid);
                if ((int)blockIdx.x >= 192) { FRESH();
                    ml_gate_tail(F, U, (const bf16*)(F.ws + WS_WML_IN) + (size_t)j * ML_NPAD * DM, (float*)(F.ws + WS_MG), args.in[I_MLBG] + j * 32, SSL_B, SSC_B, (const float*)(F.ws + WS_BVIN) + (size_t)layer * 9 * ML_NPAD, (int)blockIdx.x - 192, 64); }
#endif
            } else {
                pg8::Gemm g{U, (const bf16*)(F.ws + WS_WNA_QKV) + (size_t)j * 6144 * DM, MT, 6144, DM, DM, 1, 1}; pg8::Order8 S; S.init(MT, 6144, F.G, (int)blockIdx.x); S.rev = 1;
                pg8::EpiQKV E{(bf16*)(F.ws + WS_QKV), 6144, 8, 0.08838834764831845f * LOG2E, pg8::NormIn{SSL_B, SSC_B, (const float*)(F.ws + WS_BVIN) + (size_t)layer * 9 * ML_NPAD, 6144}};
#ifndef NO_G2
                pg8::gemm_phase<pg8::EpiQKV, pg8::Order8, true, true>(ring, g, S, E, F.tid);
#endif
            }
        }
        SEAM(pb + 1);
        if (RUN(pb + 2)) { FRESH();
#ifndef NO_SCAN
            if (!is_na) { _Pragma("unroll 1") for (int rep = 0; rep < REP_SCAN; ++rep) { FRESH(); scan_phase(F); } }
#endif
#ifndef NO_NA
            if (is_na) { _Pragma("unroll 1") for (int rep = 0; rep < REP_NA; ++rep) { FRESH(); na_phase(F, args.in[I_NARPB] + (size_t)j * 16 * 465, need_ctx); } }
#endif
        }
        SEAM(pb + 2);
        if (RUN(pb + 3)) { if (!is_na) { _Pragma("unroll 1") for (int rep = 0; rep < REP_RO; ++rep) { FRESH(); readout_phase(F, args.in[I_MLNORM] + j * DM); } } }
        if (!is_na) SEAM(pb + 3);
        if (RUN(pb + 4)) { FRESH();
            const bf16* wt = is_na ? (const bf16*)(F.ws + WS_WNA_OUT) + (size_t)j * DM * DM : (const bf16*)(F.ws + WS_WML_OUT) + (size_t)j * DM * DM;
            { pg8::Gemm g{U, wt, ML, DM, DM, DM, 1, 1}; pg8::Order8 S; S.init(ML, DM, F.G, (int)blockIdx.x); S.wgm = WGM_RES;
              ZERO_SS(SSL_B);
              pg8::EpiRes E{args.pad ? (h16*)(F.ws + WS_U) : H16, H16, mods, 2 * DM, args.pad, args.pad ? nullptr : U2, SSL_A, args.in[I_NMLP] + layer * DM, mods + 4 * DM};
              XPROBE_SET; pg8::gemm_phase<pg8::EpiRes, pg8::Order8, true, true>(ring, g, S, E, F.tid); }
            if (need_ctx) { FRESH(); pg8::Gemm g{U + (size_t)ML * DM, wt, MC, DM, DM / 4, DM, 1, 1}; pg8::SplitK4Order S{(int)blockIdx.x};
              pg8::EpiPart E{(h16*)(F.ws + WS_PC)};
              pg8::gemm_phase<pg8::EpiPart, pg8::SplitK4Order, true, true>(ring, g, S, E, F.tid); }
        }
        SEAM(pb + 4);
        if (RUN(pb + 5)) { _Pragma("unroll 1") for (int rep = 0; rep < REP_NORM; ++rep) { FRESH();
            if (need_ctx) norm_phase<false>(F, F.out, HC, args.in[I_NMLP] + layer * DM, mods, 4 * DM, false, (const h16*)(F.ws + WS_PC), mods + (size_t)8 * NMOD + 2 * DM, U2, SSL_A, SSC_A); } }
        if (need_ctx) SEAM(pb + 5);
        if (RUN(pb + 6)) { FRESH();
            pg8::Gemm g{U2, (const bf16*)(F.ws + WS_W1) + (size_t)layer * DFF * DM, mrows, DFF, DM, DM, 1, 1}; pg8::Order8 S; S.init(mrows, DFF, F.G, (int)blockIdx.x); S.rev = 1;
            pg8::EpiSqRelu E{(bf16*)(F.ws + WS_HID), DFF, pg8::NormIn{SSL_A, SSC_A, (const float*)(F.ws + WS_BVM1) + (size_t)layer * 9 * DFF, DFF}};
#ifndef NO_G4
            _Pragma("unroll 1") for (int rep = 0; rep < REP_MLP1; ++rep) { pg8::gemm_phase<pg8::EpiSqRelu, pg8::Order8, true, true>(ring, g, S, E, F.tid); }
#endif
        }
        SEAM(pb + 6);
        if (RUN(pb + 7)) { FRESH();
            const bf16* w2 = (const bf16*)(F.ws + WS_W2) + (size_t)layer * DM * DFF;
            { pg8::Gemm g{(const bf16*)(F.ws + WS_HID), w2, ML, DM, DFF, DFF, 1, 1}; pg8::Order8 S; S.init(ML, DM, F.G, (int)blockIdx.x); S.wgm = WGM_RES;
              ZERO_SS(SSL_A);
              const bool nxt = layer + 1 < DEPTH && !args.pad;
              pg8::EpiRes E{args.pad ? (h16*)(F.ws + WS_U) : H16, H16, mods, 5 * DM, args.pad, nxt ? U : nullptr, SSL_B, args.in[I_NMIX] + (layer + 1) * DM, MODS + (size_t)(layer + 1) * 9 * NMOD + DM};
              XPROBE_SET; pg8::gemm_phase<pg8::EpiRes, pg8::Order8, true, true>(ring, g, S, E, F.tid); }
            if (need_ctx) { FRESH(); pg8::Gemm g{(const bf16*)(F.ws + WS_HID) + (size_t)ML * DFF, w2, MC, DM, DFF / 4, DFF, 1, 1}; pg8::SplitK4Order S{(int)blockIdx.x};
              pg8::EpiPart E{(h16*)(F.ws + WS_PC)};
              pg8::gemm_phase<pg8::EpiPart, pg8::SplitK4Order, true, true>(ring, g, S, E, F.tid); }
        }
        SEAM(pb + 7);
    }
#undef mods
    if (RUN(N_PHASES - 1)) { FRESH(); final_norm_phase(F, args); }
#ifdef PROBE_WAIT
    if (hi - lo > 1) { unsigned long long* sum = (unsigned long long*)(F.ws + WS_CTL + 900 * 1024);
        if (threadIdx.x == 0) atomicAdd(sum, wait_acc);
        xcd_barrier(bar);
        const unsigned long long tot = __hip_atomic_load(sum, __ATOMIC_RELAXED, __HIP_MEMORY_SCOPE_AGENT) / 256ull, t0_ = __builtin_amdgcn_s_memrealtime();
        while (__builtin_amdgcn_s_memrealtime() - t0_ < tot) __builtin_amdgcn_s_sleep(8); }
#endif
#ifdef PROBE_EXTRA_BARRIERS
    if (hi - lo > 1) for (int xb = 0; xb < PROBE_EXTRA_BARRIERS; ++xb) xcd_barrier(bar);
#endif
#undef RUN
#undef U
#undef HC
#undef MODS
#undef U2
#undef H16
#undef SSL_A
#undef SSL_B
#undef SSC_A
#undef SSC_B
#undef ZERO_SS
#undef FRESH
#undef SEAM
}

extern "C" void kernel_launch(void* const* d_in, const int* in_sizes, int n_in, void* d_out, int out_size, void* d_ws, size_t ws_size, hipStream_t stream) {
    static int grid = 0;
    if (grid == 0) {
        if (n_in != 18 || out_size != ML * DM || ws_size < WS_TOTAL) { fprintf(stderr, "kernel_launch: built for 18 inputs, out of %d floats, >= %zu bytes of workspace; got n_in %d, out %d, ws %zu; nothing launched\n", ML * DM, (size_t)WS_TOTAL, n_in, out_size, ws_size); grid = -1; return; }
        int dev = 0, cus = 0, per_cu = 0;
        if (hipGetDevice(&dev) != hipSuccess || hipDeviceGetAttribute(&cus, hipDeviceAttributeMultiprocessorCount, dev) != hipSuccess) { fprintf(stderr, "kernel_launch: device query failed\n"); grid = -1; return; }
        if (hipFuncSetAttribute((const void*)fwd, hipFuncAttributeMaxDynamicSharedMemorySize, LDS_BYTES) != hipSuccess) { fprintf(stderr, "kernel_launch: hipFuncSetAttribute failed\n"); grid = -1; return; }
        if (hipOccupancyMaxActiveBlocksPerMultiprocessor(&per_cu, (const void*)fwd, NWAVES * 64, LDS_BYTES) != hipSuccess || per_cu < 1) fprintf(stderr, "kernel_launch: note: occupancy query reports %d workgroups per CU\n", per_cu);
        (void)hipGetLastError();
        if (cus < 256) { fprintf(stderr, "kernel_launch: needs 256 CUs (one resident workgroup each), device has %d; nothing launched\n", cus); grid = -1; return; }
        grid = 256;
    }
    if (grid < 0) return;
    if (hipMemsetAsync((char*)d_ws + WS_CTL, 0, CTL_ZERO_BYTES, stream) != hipSuccess) { fprintf(stderr, "kernel_launch: hipMemsetAsync failed\n"); return; }
    Args a{};
    for (int i = 0; i < 18; ++i) a.in[i] = (const float*)d_in[i];
    a.out = (float*)d_out; a.ws = (unsigned char*)d_ws;
#if MK_PER_PHASE
    for (int p = 0; p < N_PHASES; ++p) { a.ph_lo = p; a.ph_hi = p + 1; a.li = p; hipLaunchKernelGGL(fwd, dim3(grid), dim3(NWAVES * 64), LDS_BYTES, stream, a); }
#elif defined(PROBE_REP_LP)
    { int start = 0, li = 0;
      for (int layer = 0; layer < DEPTH; ++layer) { const int p = 3 + 8 * layer + PROBE_REP_LP;
          a.ph_lo = start; a.ph_hi = p + 1; a.li = li++; hipLaunchKernelGGL(fwd, dim3(grid), dim3(NWAVES * 64), LDS_BYTES, stream, a);
          if ((PROBE_LAYER_MASK >> layer) & 1) { a.ph_lo = p; a.ph_hi = p + 1; a.li = li++; a.pad = PROBE_DUMMY; hipLaunchKernelGGL(fwd, dim3(grid), dim3(NWAVES * 64), LDS_BYTES, stream, a); a.pad = 0; } start = p + 1; }
      a.ph_lo = start; a.ph_hi = N_PHASES; a.li = li++; hipLaunchKernelGGL(fwd, dim3(grid), dim3(NWAVES * 64), LDS_BYTES, stream, a); }
#elif defined(PROBE_CUT_LP)
    { int start = 0, li = 0;
      for (int layer = 0; layer < DEPTH; ++layer) { const int p = 3 + 8 * layer + PROBE_CUT_LP;
          a.ph_lo = start; a.ph_hi = p + 1; a.li = li++; hipLaunchKernelGGL(fwd, dim3(grid), dim3(NWAVES * 64), LDS_BYTES, stream, a); start = p + 1; }
      a.ph_lo = start; a.ph_hi = N_PHASES; a.li = li++; hipLaunchKernelGGL(fwd, dim3(grid), dim3(NWAVES * 64), LDS_BYTES, stream, a); }
#else
    a.ph_lo = 0; a.ph_hi = N_PHASES;
    hipLaunchKernelGGL(fwd, dim3(grid), dim3(NWAVES * 64), LDS_BYTES, stream, a);
#endif
    const hipError_t le = hipPeekAtLastError();
    if (le != hipSuccess) fprintf(stderr, "kernel_launch: launch failed: %s\n", hipGetErrorName(le));
}
```
